# Optimizing an MI355X kernel written in HIP

```python
import jax, jax.numpy as jnp
from jax import lax
import numpy as np

D_MODEL = 2048
BATCH = 1
SEQ = 16384
DEPTH = 1

ATTN_HEADS = 8
ATTN_HEAD_DIM = 128
ATTN_WIDTH = ATTN_HEADS * ATTN_HEAD_DIM
DILATED_PATTERNS = ((128, 1), (512, 4), (2048, 16))
Q_BLOCK = 128
ROPE_THETA = 500000.0
ROT_DIM = ATTN_HEAD_DIM // 4
HGRN_HEADS = 8
HGRN_EXPAND = 128
HGRN_HEAD_V = 128
HGRN_KEY_WIDTH = HGRN_HEADS * HGRN_EXPAND
HGRN_VAL_WIDTH = HGRN_HEADS * HGRN_HEAD_V
HGRN_CHUNK = 64
MIX_WIDTH = ATTN_WIDTH + HGRN_VAL_WIDTH
IN_WIDTH = 3 * ATTN_WIDTH + 2 * HGRN_KEY_WIDTH + 2 * HGRN_VAL_WIDTH
D_FF = 5632
CONV_WIDTH = 3
N_MOD = 6
EPS = 1e-6

kernel_name = "hybrid_dilated_swa_hgrn2_convffn_adaln"


def rms_norm(x, w):
    xf = x.astype(jnp.float32)
    y = xf * lax.rsqrt(jnp.mean(xf * xf, axis=-1, keepdims=True) + EPS)
    return y.astype(x.dtype) * w


def partial_rotary(x, positions):
    inv_freq = 1.0 / (ROPE_THETA ** (jnp.arange(0, ROT_DIM, 2, dtype=jnp.float32) / ROT_DIM))
    ang = positions.astype(jnp.float32)[..., None] * inv_freq
    cos = jnp.cos(ang)[:, :, None, :]
    sin = jnp.sin(ang)[:, :, None, :]
    xf = x[..., :ROT_DIM].astype(jnp.float32)
    x1, x2 = xf[..., : ROT_DIM // 2], xf[..., ROT_DIM // 2:]
    rot = jnp.concatenate([x1 * cos - x2 * sin, x2 * cos + x1 * sin], axis=-1).astype(x.dtype)
    return jnp.concatenate([rot, x[..., ROT_DIM:]], axis=-1)


def dilated_window_attention(q, k, v):
    B, S, H, Dh = q.shape
    nblk = S // Q_BLOCK
    scale = Dh ** -0.5
    qb = q.reshape(B, nblk, Q_BLOCK, H, Dh).transpose(1, 0, 2, 3, 4)

    def one_block(args):
        blk, q_blk = args
        t = blk * Q_BLOCK + jnp.arange(Q_BLOCK, dtype=jnp.int32)
        outs, lses = [], []
        for (w, d) in DILATED_PATTERNS:
            j = jnp.arange(w // d + 1, dtype=jnp.int32)
            idx = t[:, None] - d * j[None, :]
            valid = idx >= 0
            idxc = jnp.maximum(idx, 0)
            kg = jnp.take(k, idxc, axis=1)
            vg = jnp.take(v, idxc, axis=1)
            s = jnp.einsum('bqhd,bqjhd->bhqj', q_blk, kg).astype(jnp.float32) * scale
            s = jnp.where(valid[None, None], s, -jnp.inf)
            lse = jax.nn.logsumexp(s, axis=-1)
            p = jnp.exp(s - lse[..., None])
            outs.append(jnp.einsum('bhqj,bqjhd->bqhd', p.astype(v.dtype), vg).astype(jnp.float32))
            lses.append(lse)
        wmix = jax.nn.softmax(jnp.stack(lses, axis=0), axis=0)
        wmix = wmix.transpose(0, 1, 3, 2)[..., None]
        return jnp.sum(wmix * jnp.stack(outs, axis=0), axis=0).astype(q.dtype)

    o = lax.map(one_block, (jnp.arange(nblk, dtype=jnp.int32), qb))
    return o.transpose(1, 0, 2, 3, 4).reshape(B, S, H * Dh)


def hgrn2(q, f_logit, i, g, lb, gnorm_w):
    B, S, _ = q.shape
    H, K, V, C = HGRN_HEADS, HGRN_EXPAND, HGRN_HEAD_V, HGRN_CHUNK
    n = S // C
    f = lb + (1.0 - lb) * jax.nn.sigmoid(f_logit.astype(jnp.float32))
    log_f = jnp.log(f)
    kk = 1.0 - f
    qf = jax.nn.silu(q.astype(jnp.float32)) * (K ** -0.5)
    vf = i.astype(jnp.float32)

    def to_chunks(a, dim):
        return a.reshape(B, n, C, H, dim).transpose(1, 0, 3, 2, 4)

    qc, kc, lc, vc = to_chunks(qf, K), to_chunks(kk, K), to_chunks(log_f, K), to_chunks(vf, V)
    causal = jnp.tril(jnp.ones((C, C), dtype=bool))[:, :, None]

    def step(state, inp):
        q_c, k_c, l_c, v_c = inp
        b = jnp.cumsum(l_c, axis=2)
        decay = jnp.exp(jnp.where(causal, b[:, :, :, None, :] - b[:, :, None, :, :], -jnp.inf))
        a = jnp.einsum('bhtk,bhsk,bhtsk->bhts', q_c, k_c, decay)
        o = (jnp.einsum('bhtk,bhkv->bhtv', q_c * jnp.exp(b), state)
             + jnp.einsum('bhts,bhsv->bhtv', a, v_c))
        b_last = b[:, :, -1:, :]
        new_state = (jnp.exp(b_last[:, :, 0, :])[..., None] * state
                     + jnp.einsum('bhsk,bhsv->bhkv', k_c * jnp.exp(b_last - b), v_c))
        return new_state, o

    s0 = jnp.zeros((B, H, K, V), jnp.float32)
    _, o = lax.scan(step, s0, (qc, kc, lc, vc))
    o = o.transpose(1, 0, 3, 2, 4).reshape(B, S, H, V)
    o = o * lax.rsqrt(jnp.mean(o * o, axis=-1, keepdims=True) + EPS) * gnorm_w.astype(jnp.float32)
    o = o * jax.nn.silu(g.astype(jnp.float32)).reshape(B, S, H, V)
    return o.reshape(B, S, H * V).astype(q.dtype)


def causal_depthwise_conv(u, w, b):
    S = u.shape[1]
    kw = w.shape[0]
    up = jnp.pad(u, ((0, 0), (kw - 1, 0), (0, 0)))
    return sum(up[:, j:j + S] * w[j] for j in range(kw)) + b


def setup_inputs(seed: int = 0) -> dict:
    key = jax.random.key(seed)
    ks = jax.random.split(key, 16)
    f32 = jnp.float32
    nrm = lambda k, shape, s: jax.random.normal(k, shape, f32) * s
    x = jax.random.normal(ks[0], (BATCH, SEQ, D_MODEL), f32)
    c = jax.random.normal(ks[1], (BATCH, D_MODEL), f32)
    offset = jax.random.randint(ks[2], (BATCH, 1), 0, 1024, dtype=jnp.int32)
    positions = offset + jnp.arange(SEQ, dtype=jnp.int32)[None, :]
    return {
        "x": x,
        "c": c,
        "positions": positions,
        "w_ada": nrm(ks[3], (DEPTH, D_MODEL, N_MOD * D_MODEL), 0.5 * D_MODEL ** -0.5),
        "b_ada": nrm(ks[4], (DEPTH, N_MOD * D_MODEL), 0.01),
        "norm1_w": 1.0 + nrm(ks[5], (DEPTH, D_MODEL), 0.02),
        "w_in": nrm(ks[6], (DEPTH, D_MODEL, IN_WIDTH), D_MODEL ** -0.5),
        "lb_logits": nrm(ks[7], (DEPTH + 1, HGRN_KEY_WIDTH), 0.5),
        "gnorm_w": 1.0 + nrm(ks[8], (DEPTH, HGRN_HEAD_V), 0.02),
        "w_out": nrm(ks[9], (DEPTH, MIX_WIDTH, D_MODEL), MIX_WIDTH ** -0.5),
        "norm2_w": 1.0 + nrm(ks[10], (DEPTH, D_MODEL), 0.02),
        "w_up": nrm(ks[11], (DEPTH, D_MODEL, 2 * D_FF), D_MODEL ** -0.5),
        "conv_w": nrm(ks[12], (DEPTH, CONV_WIDTH, 2 * D_FF), CONV_WIDTH ** -0.5),
        "conv_b": nrm(ks[13], (DEPTH, 2 * D_FF), 0.01),
        "w_down": nrm(ks[14], (DEPTH, D_FF, D_MODEL), D_FF ** -0.5),
        "final_norm_w": 1.0 + nrm(ks[15], (D_MODEL,), 0.02),
    }


def reference(x, c, positions, w_ada, b_ada, norm1_w, w_in, lb_logits, gnorm_w, w_out,
              norm2_w, w_up, conv_w, conv_b, w_down, final_norm_w):
    B, S, _ = x.shape
    lb_all = jnp.cumsum(jax.nn.softmax(lb_logits.astype(jnp.float32), axis=0), axis=0)
    c_act = jax.nn.silu(c)
    for l in range(DEPTH):
        mod = c_act @ w_ada[l] + b_ada[l]
        sh1, sc1, g1, sh2, sc2, g2 = [m[:, None, :] for m in jnp.split(mod, N_MOD, axis=-1)]

        h = rms_norm(x, norm1_w[l]) * (1.0 + sc1) + sh1
        proj = h @ w_in[l]
        o0 = 0
        aq = proj[..., o0:o0 + ATTN_WIDTH]; o0 += ATTN_WIDTH
        ak = proj[..., o0:o0 + ATTN_WIDTH]; o0 += ATTN_WIDTH
        av = proj[..., o0:o0 + ATTN_WIDTH]; o0 += ATTN_WIDTH
        hq = proj[..., o0:o0 + HGRN_KEY_WIDTH]; o0 += HGRN_KEY_WIDTH
        hf = proj[..., o0:o0 + HGRN_KEY_WIDTH]; o0 += HGRN_KEY_WIDTH
        hi = proj[..., o0:o0 + HGRN_VAL_WIDTH]; o0 += HGRN_VAL_WIDTH
        hg = proj[..., o0:o0 + HGRN_VAL_WIDTH]

        qa = partial_rotary(aq.reshape(B, S, ATTN_HEADS, ATTN_HEAD_DIM), positions)
        ka = partial_rotary(ak.reshape(B, S, ATTN_HEADS, ATTN_HEAD_DIM), positions)
        va = av.reshape(B, S, ATTN_HEADS, ATTN_HEAD_DIM)
        y_attn = dilated_window_attention(qa, ka, va)
        y_rec = hgrn2(hq, hf, hi, hg, lb_all[l], gnorm_w[l])
        y_mix = jnp.concatenate([y_attn, y_rec], axis=-1) @ w_out[l]
        x = x + g1 * y_mix

        h = rms_norm(x, norm2_w[l]) * (1.0 + sc2) + sh2
        u = causal_depthwise_conv(h @ w_up[l], conv_w[l], conv_b[l])
        gate, up = u[..., :D_FF], u[..., D_FF:]
        x = x + g2 * ((jax.nn.silu(gate) * up) @ w_down[l])
    return rms_norm(x, final_norm_w)
```

```cpp
#include <hip/hip_runtime.h>
#include <hip/hip_cooperative_groups.h>
#include <cstdio>
#include <cstdint>
namespace cg = cooperative_groups;

#define LAS __attribute__((address_space(3)))
typedef unsigned short bf16_t;
typedef short bf16x8 __attribute__((ext_vector_type(8)));
typedef float f32x4 __attribute__((ext_vector_type(4)));
typedef float f32x16 __attribute__((ext_vector_type(16)));
typedef unsigned u32x4 __attribute__((ext_vector_type(4)));
typedef unsigned u32x2 __attribute__((ext_vector_type(2)));

#ifndef MK_SINGLE
#define MK_SINGLE 1
#endif

constexpr int S = 16384, D = 2048, INW = 7168, DFF = 5632, UPW = 11264, NMOD = 12288;
constexpr float EPS = 1e-6f;
constexpr int NPHASE = 12;
constexpr int NWAVES = 8;
constexpr int LDS_BYTES = 160 * 1024;

constexpr size_t MiB = 1u << 20;
constexpr size_t WS_CTL = 0;
constexpr size_t WS_WDOWN = 1 * MiB;
constexpr size_t WS_WUP = 23 * MiB;
constexpr size_t WS_CS = 67 * MiB;
constexpr size_t WS_LSE = 69 * MiB;
constexpr size_t WS_DBUF = 71 * MiB;
constexpr size_t WS_HALO = 72 * MiB;
constexpr size_t WS_HEAD = WS_HALO + 5767168;
constexpr size_t WS_BAR = 65536;
constexpr size_t WS_WIN = 83 * MiB;
constexpr size_t WS_WOUT = 111 * MiB;
constexpr size_t WS_H = 119 * MiB;
constexpr size_t WS_PROJ = 183 * MiB;
constexpr size_t WS_OP = 407 * MiB;
constexpr size_t WS_SBUF = WS_PROJ;
constexpr size_t WS_H2 = 83 * MiB;
constexpr size_t WS_ACT = 147 * MiB;
constexpr size_t WS_D1 = 387 * MiB;
constexpr size_t WS_D2 = 323 * MiB;
constexpr size_t WS_NEED = 503 * MiB;
constexpr size_t TSZ = (size_t)S * 1024;

__device__ __forceinline__ unsigned cvt_pk_bf16(float lo, float hi) { unsigned r; asm volatile("v_cvt_pk_bf16_f32 %0, %1, %2" : "=v"(r) : "v"(lo), "v"(hi)); return r; }
typedef __bf16 bf16x2_t __attribute__((ext_vector_type(2)));
typedef float f32x2_t __attribute__((ext_vector_type(2)));
__device__ __forceinline__ unsigned pk2_rne(float lo, float hi) { const f32x2_t f = {lo, hi}; return __builtin_bit_cast(unsigned, __builtin_convertvector(f, bf16x2_t)); }
__device__ __forceinline__ float bf2f(unsigned short b) { return __uint_as_float(((unsigned)b) << 16); }
__device__ __forceinline__ float bflo(unsigned w) { return __uint_as_float(w << 16); }
__device__ __forceinline__ float bfhi(unsigned w) { return __uint_as_float(w & 0xffff0000u); }
__device__ __forceinline__ float wave_sum(float v) {
#pragma unroll
    for (int o = 1; o < 64; o <<= 1) v += __shfl_xor(v, o);
    return v;
}
__device__ __forceinline__ float fast_sigmoid(float x) { return __builtin_amdgcn_rcpf(1.0f + __expf(-x)); }
__device__ __forceinline__ float fast_silu(float x) { return x * fast_sigmoid(x); }
__device__ __forceinline__ int crow(int reg, int h) { return (reg & 3) + 8 * (reg >> 2) + 4 * h; }
#define MFMA32(a, b, c) __builtin_amdgcn_mfma_f32_32x32x16_bf16((a), (b), (c), 0, 0, 0)

namespace pg8 {
constexpr int BM = 256, BK = 64, HALF = 128, HTB = HALF * BK * 2, STAGE_BYTES = 8 * HTB, NXCD = 8, WGM = 4;
__host__ __device__ __forceinline__ int lds_byte(int r, int c) { const int st = (r >> 4) * 2 + (c >> 5), rr = r & 15, cc = c & 31, ob = rr * 64 + cc * 2; return st * 1024 + (ob ^ (((ob >> 9) & 1) << 5)); }
__host__ __device__ __forceinline__ void stage_rc(int b, int& R, int& C) { const int st = b / 1024, sb = b % 1024, swz = sb ^ (((sb >> 9) & 1) << 5); R = (st >> 1) * 16 + swz / 64; C = (st & 1) * 32 + (swz % 64) / 2; }
__host__ __device__ __forceinline__ int perm32(int rho) { const int n = rho >> 4, i = rho & 15; return 8 * (i >> 2) + 4 * n + (i & 3); }

struct Unit { int pm, pn; };
struct Gemm { const bf16_t* A; const bf16_t* Bt; int M, N, K, lda; };

struct StaticOrder {
    int nM, nN, nwg, G, c;
    __host__ __device__ void init(int M, int N, int G_, int c_) { nM = M / BM; nN = N / BM; nwg = nM * nN; G = G_; c = c_; }
    __host__ __device__ bool next(int i, Unit& u) const {
        const long L = (long)i * G + c; if (L >= nwg) return false;
        int wgid = (int)L; { const int q = nwg / NXCD, r = nwg % NXCD, xcd = wgid % NXCD, off = wgid / NXCD; wgid = (xcd < r ? xcd * (q + 1) : r * (q + 1) + (xcd - r) * q) + off; }
        const int nig = WGM * nN, gid = wgid / nig, fm = gid * WGM, gsz = (nM - fm) < WGM ? (nM - fm) : WGM;
        u.pm = fm + ((wgid % nig) % gsz); u.pn = (wgid % nig) / gsz; return true;
    }
};

template <class Epi, class Sched>
__device__ __forceinline__ void gemm_phase(LAS unsigned char* lds, const Gemm g, const Sched& S, const Epi& E) {
    const int tid = threadIdx.x, wid = __builtin_amdgcn_readfirstlane(tid >> 6), lane = tid & 63, wr = wid >> 2, wc = wid & 3, fr = lane & 15, fq = lane >> 4;
    const int K = g.K, nt = K / BK, lda = g.lda;
    unsigned voffA[2], voffB[2];
#pragma unroll
    for (int i = 0; i < 2; ++i) { int R, C; stage_rc(tid * 16 + i * 8192, R, C); const int Rb = Epi::PERM ? ((R & ~31) + perm32(R & 31)) : R;
        voffA[i] = (unsigned)(R * lda + C) * 2u; voffB[i] = (unsigned)(Rb * K + C) * 2u; }
    const size_t kstep = (size_t)(BK * 2);
    const size_t hstepA = (size_t)HALF * lda * 2, hstepB = (size_t)HALF * K * 2;
    const size_t tstepA = 2 * hstepA, tstepB = 2 * hstepB;
    const unsigned ldsw = (unsigned)wid * 1024u;
    const int aoff = lds_byte(wr * 64 + fr, fq * 8), boff = lds_byte(wc * 32 + fr, fq * 8);
#define PG8_SA(b, h) (((b) * 2 + (h)) * HTB)
#define PG8_SB(b, h) ((4 + (b) * 2 + (h)) * HTB)
#define PG8_STAGE(bufoff, gbase, voff) do { _Pragma("unroll") for (int _i = 0; _i < 2; ++_i) \
        __builtin_amdgcn_global_load_lds((const unsigned*)((const char*)(gbase) + (voff)[_i]), (LAS unsigned*)(lds + (bufoff) + ldsw + _i * 8192), 16, 0, 0); } while (0)
#define PG8_LDA(dst, b, h) do { _Pragma("unroll") for (int m = 0; m < 4; ++m) _Pragma("unroll") for (int k = 0; k < 2; ++k) dst[m][k] = *(const LAS bf16x8*)(lds + PG8_SA(b, h) + aoff + m * 2048 + k * 1024); } while (0)
#define PG8_LDB(dst, b, h) do { _Pragma("unroll") for (int n = 0; n < 2; ++n) _Pragma("unroll") for (int k = 0; k < 2; ++k) dst[n][k] = *(const LAS bf16x8*)(lds + PG8_SB(b, h) + boff + n * 2048 + k * 1024); } while (0)
#define PG8_MMA(ai, bj, At, Bt) do { __builtin_amdgcn_s_setprio(1); _Pragma("unroll") for (int m = 0; m < 4; ++m) _Pragma("unroll") for (int n = 0; n < 2; ++n) _Pragma("unroll") for (int k = 0; k < 2; ++k) \
        acc[ai][bj][m][n] = __builtin_amdgcn_mfma_f32_16x16x32_bf16(Bt[n][k], At[m][k], acc[ai][bj][m][n], 0, 0, 0); __builtin_amdgcn_s_setprio(0); } while (0)
#define PG8_WAIT_V(n) asm volatile("s_waitcnt vmcnt(" #n ")" ::: "memory")
#define PG8_WAIT_L(n) asm volatile("s_waitcnt lgkmcnt(" #n ")" ::: "memory")
#define PG8_BAR __builtin_amdgcn_s_barrier()
#define PG8_SCHED __builtin_amdgcn_sched_barrier(0)
    Unit cur, nxt; int ui = 0;
    if (!S.next(0, cur)) return;
    f32x4 acc[2][2][4][2];
#pragma unroll
    for (int a = 0; a < 2; ++a)
#pragma unroll
        for (int b = 0; b < 2; ++b)
#pragma unroll
            for (int m = 0; m < 4; ++m)
#pragma unroll
                for (int n = 0; n < 2; ++n) acc[a][b][m][n] = (f32x4){0.f, 0.f, 0.f, 0.f};
    bf16x8 At[4][2], B0[2][2], B1[2][2];
    const char* cA = (const char*)g.A + (size_t)cur.pm * tstepA; const char* cB = (const char*)g.Bt + (size_t)cur.pn * tstepB;
    PG8_STAGE(PG8_SB(0, 0), cB, voffB); PG8_STAGE(PG8_SB(0, 1), cB + hstepB, voffB); PG8_STAGE(PG8_SA(0, 0), cA, voffA); PG8_STAGE(PG8_SA(0, 1), cA + hstepA, voffA);
    if (wr == 1) PG8_BAR;
    PG8_WAIT_V(2); PG8_BAR;
    PG8_STAGE(PG8_SB(1, 0), cB + kstep, voffB); PG8_STAGE(PG8_SA(1, 0), cA + kstep, voffA); PG8_STAGE(PG8_SB(1, 1), cB + hstepB + kstep, voffB);
    PG8_WAIT_V(6); PG8_BAR;
    for (;;) {
        const bool has_next = S.next(ui + 1, nxt);
        const char* nA = has_next ? (const char*)g.A + (size_t)nxt.pm * tstepA : cA; const char* nB = has_next ? (const char*)g.Bt + (size_t)nxt.pn * tstepB : cB;
        for (int t = 0; t < nt; t += 2) {
            const bool last = (t == nt - 2);
            const char* a1 = cA + (size_t)(t + 1) * kstep;
            const char* a2 = last ? nA : cA + (size_t)(t + 2) * kstep; const char* b2 = last ? nB : cB + (size_t)(t + 2) * kstep;
            const char* a3 = a2 + kstep; const char* b3 = b2 + kstep;
            PG8_LDB(B0, 0, 0); PG8_LDB(B1, 0, 1); PG8_SCHED; PG8_LDA(At, 0, 0); PG8_STAGE(PG8_SA(1, 1), a1 + hstepA, voffA);
            PG8_WAIT_V(8); PG8_WAIT_L(0); PG8_BAR; PG8_MMA(0, 0, At, B0); PG8_MMA(0, 1, At, B1); PG8_BAR; PG8_SCHED;
            PG8_LDA(At, 0, 1); PG8_STAGE(PG8_SB(0, 0), b2, voffB); PG8_STAGE(PG8_SB(0, 1), b2 + hstepB, voffB); PG8_STAGE(PG8_SA(0, 0), a2, voffA);
            PG8_WAIT_V(8); PG8_WAIT_L(0); PG8_BAR; PG8_MMA(1, 0, At, B0); PG8_MMA(1, 1, At, B1); PG8_BAR; PG8_SCHED;
            PG8_LDB(B0, 1, 0); PG8_LDB(B1, 1, 1); PG8_SCHED; PG8_LDA(At, 1, 0); PG8_STAGE(PG8_SA(0, 1), a2 + hstepA, voffA);
            PG8_WAIT_V(8); PG8_WAIT_L(0); PG8_BAR; PG8_MMA(0, 0, At, B0); PG8_MMA(0, 1, At, B1); PG8_BAR; PG8_SCHED;
            PG8_LDA(At, 1, 1); PG8_STAGE(PG8_SB(1, 0), b3, voffB); PG8_STAGE(PG8_SB(1, 1), b3 + hstepB, voffB); PG8_STAGE(PG8_SA(1, 0), a3, voffA);
            PG8_WAIT_V(8); PG8_WAIT_L(0); PG8_BAR; PG8_MMA(1, 0, At, B0); PG8_MMA(1, 1, At, B1); PG8_BAR; PG8_SCHED;
        }
        if (wr == 0) PG8_BAR;
        E(acc, cur, wr, wc, fr, fq);
        if (!has_next) break;
#pragma unroll
        for (int a = 0; a < 2; ++a)
#pragma unroll
            for (int b = 0; b < 2; ++b)
#pragma unroll
                for (int m = 0; m < 4; ++m)
#pragma unroll
                    for (int n = 0; n < 2; ++n) acc[a][b][m][n] = (f32x4){0.f, 0.f, 0.f, 0.f};
        cur = nxt; cA = nA; cB = nB; ++ui;
        if (wr == 1) PG8_BAR;
    }
    PG8_WAIT_V(0);
    PG8_BAR;
#undef PG8_SA
#undef PG8_SB
#undef PG8_STAGE
#undef PG8_LDA
#undef PG8_LDB
#undef PG8_MMA
#undef PG8_WAIT_V
#undef PG8_WAIT_L
#undef PG8_BAR
#undef PG8_SCHED
}
}

struct EpiProj {
    static constexpr bool PERM = true;
    bf16_t* proj; const float* cs; const float* lbl;
    __device__ __forceinline__ void operator()(const f32x4 (&acc)[2][2][4][2], const pg8::Unit& u, int wr, int wc, int fr, int fq) const {
        asm volatile("s_nop 7\n\ts_nop 7\n\ts_nop 7" ::: "memory");
        const int type = u.pn >> 2;
        bf16_t* base = proj + (size_t)type * TSZ;
        const int row0 = u.pm * 256 + wr * 64 + fr;
        const int col0 = (u.pn & 3) * 256 + wc * 32 + 8 * fq;
        const bool rot = (type <= 1) && (wc == 0);
#pragma unroll
        for (int bj = 0; bj < 2; ++bj) {
            float lb[8];
            if (type == 4) {
                const f32x4 a0 = *(const f32x4*)(lbl + col0 + bj * 128), a1 = *(const f32x4*)(lbl + col0 + bj * 128 + 4);
                const f32x4 b0 = *(const f32x4*)(lbl + 1024 + col0 + bj * 128), b1 = *(const f32x4*)(lbl + 1024 + col0 + bj * 128 + 4);
#pragma unroll
                for (int e = 0; e < 4; ++e) { lb[e] = fast_sigmoid(a0[e] - b0[e]); lb[4 + e] = fast_sigmoid(a1[e] - b1[e]); }
            } else {
#pragma unroll
                for (int e = 0; e < 8; ++e) lb[e] = 0.f;
            }
#pragma unroll
            for (int ai = 0; ai < 2; ++ai)
#pragma unroll
                for (int m = 0; m < 4; ++m) {
                    const int row = row0 + ai * 128 + m * 16;
                    float v[8];
#pragma unroll
                    for (int e = 0; e < 4; ++e) { v[e] = acc[ai][bj][m][0][e]; v[4 + e] = acc[ai][bj][m][1][e]; }
                    if (rot) {
                        const float* cp = cs + (size_t)row * 32 + 8 * (fq & 1);
                        const f32x4 c0 = *(const f32x4*)(cp), c1 = *(const f32x4*)(cp + 4), s0 = *(const f32x4*)(cp + 16), s1 = *(const f32x4*)(cp + 20);
                        const float sg = (fq < 2) ? -1.f : 1.f;
#pragma unroll
                        for (int e = 0; e < 8; ++e) {
                            const float pv = __shfl_xor(v[e], 32);
                            const float cc = (e < 4) ? c0[e & 3] : c1[e & 3], ss = (e < 4) ? s0[e & 3] : s1[e & 3];
                            v[e] = v[e] * cc + sg * pv * ss;
                        }
                    } else if (type == 3) {
#pragma unroll
                        for (int e = 0; e < 8; ++e) v[e] = fast_silu(v[e]) * 0.08838834764831845f;
                    } else if (type == 4) {
#pragma unroll
                        for (int e = 0; e < 8; ++e) { const float f = lb[e] + (1.f - lb[e]) * fast_sigmoid(v[e]); v[e] = __logf(f); }
                    } else if (type == 6) {
#pragma unroll
                        for (int e = 0; e < 8; ++e) v[e] = fast_silu(v[e]);
                    }
                    u32x4 w; w.x = pk2_rne(v[0], v[1]); w.y = pk2_rne(v[2], v[3]); w.z = pk2_rne(v[4], v[5]); w.w = pk2_rne(v[6], v[7]);
                    __builtin_nontemporal_store(w, (u32x4*)(base + (size_t)row * 1024 + col0 + bj * 128));
                }
        }
    }
};
struct EpiDelta {
    static constexpr bool PERM = true;
    bf16_t* O; const float* g;
    __device__ __forceinline__ void operator()(const f32x4 (&acc)[2][2][4][2], const pg8::Unit& u, int wr, int wc, int fr, int fq) const {
        asm volatile("s_nop 7\n\ts_nop 7\n\ts_nop 7" ::: "memory");
        const int row0 = u.pm * 256 + wr * 64 + fr, col0 = u.pn * 256 + wc * 32 + 8 * fq;
        f32x4 gv[2][2];
#pragma unroll
        for (int bj = 0; bj < 2; ++bj)
#pragma unroll
            for (int n = 0; n < 2; ++n) gv[bj][n] = *(const f32x4*)(g + col0 + bj * 128 + 4 * n);
#pragma unroll
        for (int ai = 0; ai < 2; ++ai)
#pragma unroll
            for (int m = 0; m < 4; ++m) {
                bf16_t* rowp = O + (size_t)(row0 + ai * 128 + m * 16) * D + col0;
#pragma unroll
                for (int bj = 0; bj < 2; ++bj) {
                    const f32x4 v0 = acc[ai][bj][m][0] * gv[bj][0], v1 = acc[ai][bj][m][1] * gv[bj][1];
                    u32x4 w; w.x = pk2_rne(v0[0], v0[1]); w.y = pk2_rne(v0[2], v0[3]); w.z = pk2_rne(v1[0], v1[1]); w.w = pk2_rne(v1[2], v1[3]);
                    *(u32x4*)(rowp + bj * 128) = w;
                }
            }
    }
};
__device__ __forceinline__ float dpp_shr1(float old, float src) { return __int_as_float(__builtin_amdgcn_update_dpp(__float_as_int(old), __float_as_int(src), 0x111, 0xf, 0xf, false)); }
__device__ __forceinline__ float dpp_shr2(float old, float src) { return __int_as_float(__builtin_amdgcn_update_dpp(__float_as_int(old), __float_as_int(src), 0x112, 0xf, 0xf, false)); }
__device__ __forceinline__ float dpp_ror1(float src) { return __int_as_float(__builtin_amdgcn_mov_dpp(__float_as_int(src), 0x121, 0xf, 0xf, true)); }
__device__ __forceinline__ float dpp_ror2(float src) { return __int_as_float(__builtin_amdgcn_mov_dpp(__float_as_int(src), 0x122, 0xf, 0xf, true)); }
struct EpiUpConv {
    static constexpr bool PERM = true;
    bf16_t* ACT; float* head; float* halo; const float* cw; const float* cb; LAS float* xb;
    __device__ __forceinline__ void operator()(const f32x4 (&acc)[2][2][4][2], const pg8::Unit& u, int wr, int wc, int fr, int fq) const {
        asm volatile("s_nop 7\n\ts_nop 7\n\ts_nop 7" ::: "memory");
        const int cc0 = wc * 32 + 8 * fq;
        if (fr >= 14) {
#pragma unroll
            for (int ai = 0; ai < 2; ++ai)
#pragma unroll
                for (int bj = 0; bj < 2; ++bj)
#pragma unroll
                    for (int n = 0; n < 2; ++n) *(LAS f32x4*)(xb + ((2 * ai + wr) * 2 + (fr - 14)) * 256 + bj * 128 + cc0 + 4 * n) = acc[ai][bj][3][n];
            if (wr == 1) {
#pragma unroll
                for (int bj = 0; bj < 2; ++bj)
#pragma unroll
                    for (int n = 0; n < 2; ++n) *(f32x4*)(halo + ((size_t)u.pm * 2 + (fr - 14)) * UPW + u.pn * 256 + bj * 128 + cc0 + 4 * n) = acc[1][bj][3][n];
            }
        }
        if (wr == 0 && fr < 2) {
#pragma unroll
            for (int bj = 0; bj < 2; ++bj)
#pragma unroll
                for (int n = 0; n < 2; ++n) *(f32x4*)(head + ((size_t)u.pm * 2 + fr) * UPW + u.pn * 256 + bj * 128 + cc0 + 4 * n) = acc[0][bj][0][n];
        }
        asm volatile("s_waitcnt lgkmcnt(0)" ::: "memory"); __builtin_amdgcn_s_barrier(); asm volatile("" ::: "memory");
        const int row0 = u.pm * 256 + wr * 64 + fr;
        u32x2 lo[2][4];
#pragma unroll
        for (int n = 0; n < 2; ++n) {
            const int jg = u.pn * 128 + cc0 + 4 * n;
            const f32x4 g0w = *(const f32x4*)(cw + jg), g1w = *(const f32x4*)(cw + UPW + jg), g2w = *(const f32x4*)(cw + 2 * UPW + jg), gb = *(const f32x4*)(cb + jg);
            const f32x4 u0w = *(const f32x4*)(cw + DFF + jg), u1w = *(const f32x4*)(cw + UPW + DFF + jg), u2w = *(const f32x4*)(cw + 2 * UPW + DFF + jg), ub = *(const f32x4*)(cb + DFF + jg);
#pragma unroll
            for (int ai = 0; ai < 2; ++ai) {
                const int gi = 2 * ai + wr;
                f32x4 pg1 = (f32x4){0.f, 0.f, 0.f, 0.f}, pg2 = pg1, pu1 = pg1, pu2 = pg1;
                if (gi > 0) {
                    const LAS float* xp = xb + ((gi - 1) * 2) * 256 + cc0 + 4 * n;
                    pg1 = *(const LAS f32x4*)(xp + 256); pu1 = *(const LAS f32x4*)(xp + 256 + 128);
                    pg2 = *(const LAS f32x4*)(xp + (fr & 1) * 256); pu2 = *(const LAS f32x4*)(xp + (fr & 1) * 256 + 128);
                }
#pragma unroll
                for (int m = 0; m < 4; ++m) {
                    float a[4];
#pragma unroll
                    for (int e = 0; e < 4; ++e) {
                        const float gc = acc[ai][0][m][n][e], uc = acc[ai][1][m][n][e];
                        float og1, og2, ou1, ou2;
                        if (m == 0) { og1 = pg1[e]; og2 = pg2[e]; ou1 = pu1[e]; ou2 = pu2[e]; }
                        else { const float gp = acc[ai][0][m - 1][n][e], up = acc[ai][1][m - 1][n][e]; og1 = dpp_ror1(gp); og2 = dpp_ror2(gp); ou1 = dpp_ror1(up); ou2 = dpp_ror2(up); }
                        const float gm1 = dpp_shr1(og1, gc), gm2 = dpp_shr2(og2, gc), um1 = dpp_shr1(ou1, uc), um2 = dpp_shr2(ou2, uc);
                        const float yg = g0w[e] * gm2 + g1w[e] * gm1 + g2w[e] * gc + gb[e];
                        const float yu = u0w[e] * um2 + u1w[e] * um1 + u2w[e] * uc + ub[e];
                        a[e] = fast_silu(yg) * yu;
                    }
                    u32x2 pk; pk.x = cvt_pk_bf16(a[0], a[1]); pk.y = cvt_pk_bf16(a[2], a[3]);
                    if (n == 0) lo[ai][m] = pk;
                    else {
                        const bool skip = (gi == 0) && (m == 0) && (fr < 2);
                        if (!skip) *(u32x4*)(ACT + (size_t)(row0 + ai * 128 + m * 16) * DFF + u.pn * 128 + cc0) = (u32x4){lo[ai][m].x, lo[ai][m].y, pk.x, pk.y};
                    }
                }
            }
        }
    }
};

struct Ctx {
    LAS unsigned char* lds; unsigned char* ws; float* out;
    const float *x, *c, *w_ada, *b_ada, *norm1_w, *w_in, *lb_logits, *gnorm_w, *w_out, *norm2_w, *w_up, *conv_w, *conv_b, *w_down, *final_w;
    const int* pos;
    int tid, lane, wave, G, gw, NGW;
};

__device__ __forceinline__ void transpose_item(const float* __restrict__ W, int K, int N, bf16_t* __restrict__ WT, LAS float* scr, int item, int lane, bool upmap = false) {
    const int nblk = N >> 6, kb = item / nblk, nb = item - kb * nblk, k0 = kb * 64, n0s = nb * 64;
    const int n0 = !upmap ? n0s : (n0s < DFF ? 256 * (n0s >> 7) + (n0s & 127) : 256 * ((n0s - DFF) >> 7) + 128 + ((n0s - DFF) & 127));
    const float* src = W + (size_t)k0 * N + n0s + lane;
#pragma unroll 16
    for (int i = 0; i < 64; ++i) scr[i * 65 + lane] = __builtin_nontemporal_load(src + (size_t)i * N);
    __builtin_amdgcn_wave_barrier();
    const int cch = lane & 7;
#pragma unroll
    for (int j = 0; j < 8; ++j) {
        const int n = (lane >> 3) + 8 * j; const LAS float* s = scr + (8 * cch) * 65 + n;
        u32x4 o; o.x = pk2_rne(s[0], s[65]); o.y = pk2_rne(s[2 * 65], s[3 * 65]); o.z = pk2_rne(s[4 * 65], s[5 * 65]); o.w = pk2_rne(s[6 * 65], s[7 * 65]);
        *(u32x4*)(WT + (size_t)(n0 + n) * K + k0 + 8 * cch) = o;
    }
    __builtin_amdgcn_wave_barrier();
}

__device__ __forceinline__ void phase_prologue(Ctx& X) {
    LAS float* scr = (LAS float*)(X.lds + X.wave * 16640);
    constexpr int I_IN = (D / 64) * (INW / 64), I_OUT = (D / 64) * (D / 64), I_UP = (D / 64) * (UPW / 64), I_DN = (DFF / 64) * (D / 64);
    constexpr int NIT = I_IN + I_OUT + I_UP + I_DN;
    bf16_t* win = (bf16_t*)(X.ws + WS_WIN); bf16_t* wout = (bf16_t*)(X.ws + WS_WOUT); bf16_t* wup = (bf16_t*)(X.ws + WS_WUP); bf16_t* wdn = (bf16_t*)(X.ws + WS_WDOWN);
    float* mod = (float*)(X.ws + WS_CTL);
    for (int task = X.gw; task < 48 * 32; task += X.NGW) {
        const int cb = task % 48, ks = task / 48;
        const f32x4* wp = (const f32x4*)(X.w_ada + (size_t)(ks * 64) * NMOD + cb * 256) + X.lane;
        f32x4 a = (f32x4){0.f, 0.f, 0.f, 0.f};
#pragma unroll 8
        for (int i = 0; i < 64; ++i) { const float cv = X.c[ks * 64 + i]; const float sv = cv / (1.f + __expf(-cv)); a += __builtin_nontemporal_load(wp + (size_t)i * (NMOD / 4)) * sv; }
        if (ks == 0) a += *((const f32x4*)(X.b_ada + cb * 256) + X.lane);
        float* mp = mod + cb * 256 + X.lane * 4;
        atomicAdd(mp + 0, a[0]); atomicAdd(mp + 1, a[1]); atomicAdd(mp + 2, a[2]); atomicAdd(mp + 3, a[3]);
    }
    for (int it = X.gw; it < NIT; it += X.NGW) {
        int r = it;
        if (r < I_IN) { transpose_item(X.w_in, D, INW, win, scr, r, X.lane); continue; } r -= I_IN;
        if (r < I_OUT) { transpose_item(X.w_out, D, D, wout, scr, r, X.lane); continue; } r -= I_OUT;
        if (r < I_UP) { transpose_item(X.w_up, D, UPW, wup, scr, r, X.lane, true); continue; } r -= I_UP;
        transpose_item(X.w_down, DFF, D, wdn, scr, r, X.lane);
    }
}

__device__ __forceinline__ void rows_norm_mod(Ctx& X, const float* src, const bf16_t* delta, float* x1out, const float* w, const float* sc, const float* sh, bf16_t* dst, bool do_cs) {
    f32x4 pa[8], pb[8];
#pragma unroll
    for (int j = 0; j < 8; ++j) { const int col = 4 * X.lane + 256 * j; pa[j] = *(const f32x4*)(w + col) * (*(const f32x4*)(sc + col) + 1.f); pb[j] = *(const f32x4*)(sh + col); }
    for (int row = X.gw; row < S; row += X.NGW) {
        const f32x4* xr = (const f32x4*)(src + (size_t)row * D) + X.lane;
        f32x4 v[8]; float ss = 0.f;
#pragma unroll
        for (int j = 0; j < 8; ++j) v[j] = xr[64 * j];
        if (delta) {
            const u32x2* dr = (const u32x2*)(delta + (size_t)row * D) + X.lane;
#pragma unroll
            for (int j = 0; j < 8; ++j) { const u32x2 d2 = dr[64 * j]; v[j][0] += bflo(d2.x); v[j][1] += bfhi(d2.x); v[j][2] += bflo(d2.y); v[j][3] += bfhi(d2.y); }
            if (x1out) {
                f32x4* xo = (f32x4*)(x1out + (size_t)row * D) + X.lane;
#pragma unroll
                for (int j = 0; j < 8; ++j) xo[64 * j] = v[j];
            }
        }
#pragma unroll
        for (int j = 0; j < 8; ++j) ss += (v[j][0] * v[j][0] + v[j][1] * v[j][1]) + (v[j][2] * v[j][2] + v[j][3] * v[j][3]);
        const float r = rsqrtf(wave_sum(ss) * (1.f / D) + EPS);
        u32x2* o8 = (u32x2*)(dst + (size_t)row * D) + X.lane;
#pragma unroll
        for (int j = 0; j < 8; ++j) {
            const f32x4 y = (v[j] * r) * pa[j] + pb[j];
            u32x2 p; p.x = pk2_rne(y[0], y[1]); p.y = pk2_rne(y[2], y[3]); o8[64 * j] = p;
        }
    }
    if (do_cs) {
        const int gt = blockIdx.x * 512 + X.tid, NT = X.G * 512;
        float* cs = (float*)(X.ws + WS_CS);
        for (int idx = gt; idx < S * 16; idx += NT) {
            const int rw = idx >> 4, i = idx & 15;
            const float invf = 1.0f / powf(500000.0f, (float)(2 * i) * (1.0f / 32.0f));
            const float ang = (float)X.pos[rw] * invf;
            cs[(size_t)rw * 32 + i] = cosf(ang); cs[(size_t)rw * 32 + 16 + i] = sinf(ang);
        }
    }
}

__device__ __forceinline__ void rows_final(Ctx& X) {
    const bf16_t* d1 = (const bf16_t*)(X.ws + WS_D1); const bf16_t* d2 = (const bf16_t*)(X.ws + WS_D2);
    f32x4 fw[8];
#pragma unroll
    for (int j = 0; j < 8; ++j) fw[j] = *(const f32x4*)(X.final_w + 4 * X.lane + 256 * j);
    for (int row = X.gw; row < S; row += X.NGW) {
        const f32x4* xr = (const f32x4*)(X.x + (size_t)row * D) + X.lane;
        f32x4* orow = (f32x4*)(X.out + (size_t)row * D) + X.lane;
        const u32x2* ar = (const u32x2*)(d1 + (size_t)row * D) + X.lane; const u32x2* br = (const u32x2*)(d2 + (size_t)row * D) + X.lane;
        f32x4 v[8]; float ss = 0.f;
#pragma unroll
        for (int j = 0; j < 8; ++j) { v[j] = __builtin_nontemporal_load(xr + 64 * j); const u32x2 a2 = __builtin_nontemporal_load(ar + 64 * j), b2 = __builtin_nontemporal_load(br + 64 * j);
            v[j][0] += bflo(a2.x) + bflo(b2.x); v[j][1] += bfhi(a2.x) + bfhi(b2.x); v[j][2] += bflo(a2.y) + bflo(b2.y); v[j][3] += bfhi(a2.y) + bfhi(b2.y); }
#pragma unroll
        for (int j = 0; j < 8; ++j) ss += (v[j][0] * v[j][0] + v[j][1] * v[j][1]) + (v[j][2] * v[j][2] + v[j][3] * v[j][3]);
        const float r = rsqrtf(wave_sum(ss) * (1.f / D) + EPS);
#pragma unroll
        for (int j = 0; j < 8; ++j) __builtin_nontemporal_store((v[j] * r) * fw[j], orow + 64 * j);
    }
}

typedef short s16x4 __attribute__((ext_vector_type(4)));
template <int S2>
__device__ __forceinline__ void tr_load8(unsigned addr, s16x4 (&t)[8]) {
    asm volatile("ds_read_b64_tr_b16 %0, %8 offset:%9\n\t"
                 "ds_read_b64_tr_b16 %1, %8 offset:%10\n\t"
                 "ds_read_b64_tr_b16 %2, %8 offset:%11\n\t"
                 "ds_read_b64_tr_b16 %3, %8 offset:%12\n\t"
                 "ds_read_b64_tr_b16 %4, %8 offset:%13\n\t"
                 "ds_read_b64_tr_b16 %5, %8 offset:%14\n\t"
                 "ds_read_b64_tr_b16 %6, %8 offset:%15\n\t"
                 "ds_read_b64_tr_b16 %7, %8 offset:%16\n\t"
                 "s_waitcnt lgkmcnt(0)"
                 : "=&v"(t[0]), "=&v"(t[1]), "=&v"(t[2]), "=&v"(t[3]), "=&v"(t[4]), "=&v"(t[5]), "=&v"(t[6]), "=&v"(t[7])
                 : "v"(addr), "i"(16 * S2 * 272 + 0), "i"(16 * S2 * 272 + 8 * 272 + 0), "i"(16 * S2 * 272 + 64), "i"(16 * S2 * 272 + 8 * 272 + 64),
                   "i"(16 * S2 * 272 + 128), "i"(16 * S2 * 272 + 8 * 272 + 128), "i"(16 * S2 * 272 + 192), "i"(16 * S2 * 272 + 8 * 272 + 192)
                 : "memory");
}
template <int S2>
__device__ __forceinline__ void tr_issue8(unsigned addr, s16x4 (&t)[8]) {
    asm volatile("ds_read_b64_tr_b16 %0, %8 offset:%9\n\t"
                 "ds_read_b64_tr_b16 %1, %8 offset:%10\n\t"
                 "ds_read_b64_tr_b16 %2, %8 offset:%11\n\t"
                 "ds_read_b64_tr_b16 %3, %8 offset:%12\n\t"
                 "ds_read_b64_tr_b16 %4, %8 offset:%13\n\t"
                 "ds_read_b64_tr_b16 %5, %8 offset:%14\n\t"
                 "ds_read_b64_tr_b16 %6, %8 offset:%15\n\t"
                 "ds_read_b64_tr_b16 %7, %8 offset:%16"
                 : "=&v"(t[0]), "=&v"(t[1]), "=&v"(t[2]), "=&v"(t[3]), "=&v"(t[4]), "=&v"(t[5]), "=&v"(t[6]), "=&v"(t[7])
                 : "v"(addr), "i"(16 * S2 * 272 + 0), "i"(16 * S2 * 272 + 8 * 272 + 0), "i"(16 * S2 * 272 + 64), "i"(16 * S2 * 272 + 8 * 272 + 64),
                   "i"(16 * S2 * 272 + 128), "i"(16 * S2 * 272 + 8 * 272 + 128), "i"(16 * S2 * 272 + 192), "i"(16 * S2 * 272 + 8 * 272 + 192)
                 : "memory");
}
__device__ __forceinline__ void tr_wait8(s16x4 (&t)[8]) {
    asm volatile("s_waitcnt lgkmcnt(0)" : "+v"(t[0]), "+v"(t[1]), "+v"(t[2]), "+v"(t[3]), "+v"(t[4]), "+v"(t[5]), "+v"(t[6]), "+v"(t[7]) : : "memory");
}
__device__ __forceinline__ void attn_item(int id, const bf16_t* __restrict__ AQ, const bf16_t* __restrict__ AK, const bf16_t* __restrict__ AV, bf16_t* __restrict__ OP, float* __restrict__ LSE,
                                          LAS bf16_t* kl, LAS bf16_t* vl, int lane) {
    const int p = id >> 12, rem = id & 4095, hd = rem >> 9, tl = rem & 511;
    const int lg = (p == 0) ? 0 : (p == 1) ? 2 : 4, dl = 1 << lg;
    const int res = tl >> (9 - lg), tt = tl & ((512 >> lg) - 1), tau0 = tt * 32;
    const int r = lane & 31, h = lane >> 5;
    const size_t qtok = (size_t)(res + dl * (tau0 + r));
    const int kt0 = (tau0 >= 128) ? 0 : ((128 - tau0) >> 5);
    const int lkey = lane >> 4, lch = lane & 15, rr = r - 4 * h;
    u32x4 kr[8], vr[8];
    const unsigned istep = (unsigned)(4 * dl) * 2048u, tstep = (unsigned)(32 * dl) * 2048u;
    unsigned voff = (unsigned)((res + dl * (tau0 - 128 + 32 * kt0 + lkey)) * 1024 + hd * 128 + 8 * lch) * 2u;
    {
#pragma unroll
        for (int it = 0; it < 8; ++it) { kr[it] = *(const u32x4*)((const char*)AK + (voff + it * istep)); vr[it] = *(const u32x4*)((const char*)AV + (voff + it * istep)); }
    }
    bf16x8 qf[8];
#pragma unroll
    for (int j = 0; j < 8; ++j) qf[j] = *(const bf16x8*)(AQ + qtok * 1024 + hd * 128 + 16 * j + 8 * h);
    f32x16 o[4];
#pragma unroll
    for (int dt = 0; dt < 4; ++dt)
#pragma unroll
        for (int i = 0; i < 16; ++i) o[dt][i] = 0.f;
    float mrun = -INFINITY, lrun = 0.f;
    const float scl = 0.08838834764831845f * 1.4426950408889634f;
    const unsigned vaddr = (unsigned)(size_t)vl + (unsigned)(((4 * (lane >> 5) + ((lane & 15) >> 2)) * 136 + 16 * ((lane >> 4) & 1) + 4 * (lane & 3)) * 2);
    for (int kt = kt0; kt < 5; ++kt) {
#pragma unroll
        for (int it = 0; it < 8; ++it) { *(LAS u32x4*)(kl + (4 * it + lkey) * 136 + 8 * lch) = kr[it]; *(LAS u32x4*)(vl + (4 * it + lkey) * 136 + 8 * lch) = vr[it]; }
        if (kt < 4) {
            voff += tstep;
#pragma unroll
            for (int it = 0; it < 8; ++it) { kr[it] = *(const u32x4*)((const char*)AK + (voff + it * istep)); vr[it] = *(const u32x4*)((const char*)AV + (voff + it * istep)); }
        }
        __builtin_amdgcn_wave_barrier();
        f32x16 s;
#pragma unroll
        for (int i = 0; i < 16; ++i) s[i] = 0.f;
        {
            bf16x8 kf[8];
#pragma unroll
            for (int j = 0; j < 8; ++j) kf[j] = *(const LAS bf16x8*)(kl + r * 136 + 16 * j + 8 * h);
            __builtin_amdgcn_sched_barrier(0);
#pragma unroll
            for (int j = 0; j < 8; ++j) s = MFMA32(kf[j], qf[j], s);
        }
        s16x4 tq0[8];
        tr_issue8<0>(vaddr, tq0);
        if (kt == 0) {
#pragma unroll
            for (int i = 0; i < 16; ++i) s[i] = (((i & 3) + 8 * (i >> 2)) >= rr) ? s[i] : -INFINITY;
        } else if (kt == 4) {
#pragma unroll
            for (int i = 0; i < 16; ++i) s[i] = (((i & 3) + 8 * (i >> 2)) <= rr) ? s[i] : -INFINITY;
        }
        float mx = fmaxf(fmaxf(s[0], s[1]), fmaxf(s[2], s[3]));
#pragma unroll
        for (int i = 4; i < 16; i += 4) mx = fmaxf(mx, fmaxf(fmaxf(s[i], s[i + 1]), fmaxf(s[i + 2], s[i + 3])));
        mx = fmaxf(mx, __shfl_xor(mx, 32));
        const float mnew = fmaxf(mrun, mx * scl);
        const float alpha = __builtin_amdgcn_exp2f(mrun - mnew);
        float rs = 0.f;
#pragma unroll
        for (int i = 0; i < 16; ++i) { s[i] = __builtin_amdgcn_exp2f(__builtin_fmaf(s[i], scl, -mnew)); rs += s[i]; }
        rs += __shfl_xor(rs, 32);
        lrun = lrun * alpha + rs; mrun = mnew;
        if (__builtin_amdgcn_readfirstlane(__any(alpha != 1.0f) ? 1 : 0)) {
#pragma unroll
            for (int dt = 0; dt < 4; ++dt)
#pragma unroll
                for (int i = 0; i < 16; ++i) o[dt][i] *= alpha;
        }
        bf16x8 pf[2];
#pragma unroll
        for (int s2 = 0; s2 < 2; ++s2) {
            u32x4 w; w.x = pk2_rne(s[8 * s2 + 0], s[8 * s2 + 1]); w.y = pk2_rne(s[8 * s2 + 2], s[8 * s2 + 3]); w.z = pk2_rne(s[8 * s2 + 4], s[8 * s2 + 5]); w.w = pk2_rne(s[8 * s2 + 6], s[8 * s2 + 7]);
            pf[s2] = __builtin_bit_cast(bf16x8, w);
        }
        {
            s16x4 tq1[8];
            tr_wait8(tq0);
            tr_issue8<1>(vaddr, tq1);
#pragma unroll
            for (int dt = 0; dt < 4; ++dt) { const bf16x8 af = __builtin_shufflevector(tq0[2 * dt], tq0[2 * dt + 1], 0, 1, 2, 3, 4, 5, 6, 7); o[dt] = MFMA32(af, pf[0], o[dt]); }
            tr_wait8(tq1);
#pragma unroll
            for (int dt = 0; dt < 4; ++dt) { const bf16x8 af = __builtin_shufflevector(tq1[2 * dt], tq1[2 * dt + 1], 0, 1, 2, 3, 4, 5, 6, 7); o[dt] = MFMA32(af, pf[1], o[dt]); }
        }
        __builtin_amdgcn_wave_barrier();
    }
    const float inv = 1.0f / lrun;
    bf16_t* op = OP + (size_t)p * TSZ + qtok * 1024 + hd * 128 + 4 * h;
#pragma unroll
    for (int dt = 0; dt < 4; ++dt)
#pragma unroll
        for (int g = 0; g < 4; ++g) {
            u32x2 w; w.x = pk2_rne(o[dt][4 * g] * inv, o[dt][4 * g + 1] * inv); w.y = pk2_rne(o[dt][4 * g + 2] * inv, o[dt][4 * g + 3] * inv);
            *(u32x2*)(op + 32 * dt + 8 * g) = w;
        }
    if (h == 0) LSE[((size_t)p * 8 + hd) * S + qtok] = mrun + __log2f(lrun);
}

#define ATT_TILE_VALID(T) (((T) >= 0) && ((T) < nq + 4) && (32 * (x0 + (T)) - 128 >= 0))
#define ATT_XL(T) (((T) < w) ? w : (w + 8 * ((((T) - w) >> 3) < (nq >> 3) - 1 ? (((T) - w) >> 3) : (nq >> 3) - 1)))
#define ATT_VOFF(T) ((unsigned)((res + dl * (32 * (x0 + (T)) - 128 + myrow)) * 1024 + hd * 128 + 8 * lch) * 2u)
#define ATT_BOOK(T) do { const int t1_ = (T) + 1, xl1_ = ATT_XL(t1_), kt1_ = t1_ - xl1_; \
        if (kt1_ >= 0 && kt1_ <= 4 && ATT_TILE_VALID(t1_) && (kt1_ == 0 || !ATT_TILE_VALID(t1_ - 1))) { \
            qtok = (size_t)(res + dl * (32 * (x0 + xl1_) + r)); \
            _Pragma("unroll") for (int j = 0; j < 8; ++j) qf[j] = *(const bf16x8*)(AQ + qtok * 1024 + hd * 128 + 16 * j + 8 * h); \
            _Pragma("unroll") for (int dt = 0; dt < 4; ++dt) _Pragma("unroll") for (int i = 0; i < 16; ++i) o[dt][i] = 0.f; \
            mrun = -INFINITY; lrun = 0.f; } } while (0)
#define ATT_STEP(T, KS, VS, KW, VW, KR, VADDR) do { \
        if (ATT_TILE_VALID((T) + 1)) { *(LAS u32x4*)((KW) + myrow * 136 + 8 * lch) = KS; *(LAS u32x4*)((VW) + myrow * 136 + 8 * lch) = VS; } \
        if (ATT_TILE_VALID((T) + 3)) { const unsigned vo_ = ATT_VOFF((T) + 3); KS = *(const u32x4*)((const char*)AK + vo_); VS = *(const u32x4*)((const char*)AV + vo_); } \
        ATT_BOOK(T); \
        { const int xl_ = ATT_XL(T), kt_ = (T) - xl_; \
          if (kt_ >= 0 && kt_ <= 4 && ATT_TILE_VALID(T)) attn_tile(KR, VADDR, kt_, qf, o, mrun, lrun, r, h, rr, p, hd, qtok, OP, LSE); } \
        asm volatile("s_waitcnt lgkmcnt(0)" ::: "memory"); __builtin_amdgcn_s_barrier(); asm volatile("" ::: "memory"); } while (0)

__device__ __forceinline__ void attn_tile(const LAS bf16_t* kl, unsigned vaddr, int kt, const bf16x8 (&qf)[8], f32x16 (&o)[4], float& mrun, float& lrun, int r, int h, int rr, int p, int hd, size_t qtok,
                                          bf16_t* __restrict__ OP, float* __restrict__ LSE) {
    const float scl = 0.08838834764831845f * 1.4426950408889634f;
    f32x16 s, sb;
#pragma unroll
    for (int i = 0; i < 16; ++i) { s[i] = 0.f; sb[i] = 0.f; }
    {
        bf16x8 kf[8];
#pragma unroll
        for (int j = 0; j < 8; ++j) kf[j] = *(const LAS bf16x8*)(kl + r * 136 + 16 * j + 8 * h);
        __builtin_amdgcn_sched_barrier(0);
#pragma unroll
        for (int j = 0; j < 8; j += 2) { s = MFMA32(kf[j], qf[j], s); sb = MFMA32(kf[j + 1], qf[j + 1], sb); }
    }
#pragma unroll
    for (int i = 0; i < 16; ++i) s[i] += sb[i];
    s16x4 tq0[8];
    tr_issue8<0>(vaddr, tq0);
    if (kt == 0) {
#pragma unroll
        for (int i = 0; i < 16; ++i) s[i] = (((i & 3) + 8 * (i >> 2)) >= rr) ? s[i] : -INFINITY;
    } else if (kt == 4) {
#pragma unroll
        for (int i = 0; i < 16; ++i) s[i] = (((i & 3) + 8 * (i >> 2)) <= rr) ? s[i] : -INFINITY;
    }
    float mx = fmaxf(fmaxf(s[0], s[1]), fmaxf(s[2], s[3]));
#pragma unroll
    for (int i = 4; i < 16; i += 4) mx = fmaxf(mx, fmaxf(fmaxf(s[i], s[i + 1]), fmaxf(s[i + 2], s[i + 3])));
    { const auto pr = __builtin_amdgcn_permlane32_swap(__float_as_uint(mx), __float_as_uint(mx), false, false); mx = fmaxf(__uint_as_float(pr[0]), __uint_as_float(pr[1])); }
    const float mnew = fmaxf(mrun, mx * scl);
    const float alpha = __builtin_amdgcn_exp2f(mrun - mnew);
    float rs = 0.f;
#pragma unroll
    for (int i = 0; i < 16; ++i) { s[i] = __builtin_amdgcn_exp2f(__builtin_fmaf(s[i], scl, -mnew)); rs += s[i]; }
    { const auto pr = __builtin_amdgcn_permlane32_swap(__float_as_uint(rs), __float_as_uint(rs), false, false); rs = __uint_as_float(pr[0]) + __uint_as_float(pr[1]); }
    lrun = lrun * alpha + rs; mrun = mnew;
    if (__builtin_amdgcn_readfirstlane(__any(alpha != 1.0f) ? 1 : 0)) {
#pragma unroll
        for (int dt = 0; dt < 4; ++dt)
#pragma unroll
            for (int i = 0; i < 16; ++i) o[dt][i] *= alpha;
    }
    bf16x8 pf[2];
#pragma unroll
    for (int s2 = 0; s2 < 2; ++s2) {
        u32x4 wv; wv.x = pk2_rne(s[8 * s2 + 0], s[8 * s2 + 1]); wv.y = pk2_rne(s[8 * s2 + 2], s[8 * s2 + 3]); wv.z = pk2_rne(s[8 * s2 + 4], s[8 * s2 + 5]); wv.w = pk2_rne(s[8 * s2 + 6], s[8 * s2 + 7]);
        pf[s2] = __builtin_bit_cast(bf16x8, wv);
    }
    {
        s16x4 tq1[8];
        tr_wait8(tq0);
        tr_issue8<1>(vaddr, tq1);
#pragma unroll
        for (int dt = 0; dt < 4; ++dt) { const bf16x8 af = __builtin_shufflevector(tq0[2 * dt], tq0[2 * dt + 1], 0, 1, 2, 3, 4, 5, 6, 7); o[dt] = MFMA32(af, pf[0], o[dt]); }
        tr_wait8(tq1);
#pragma unroll
        for (int dt = 0; dt < 4; ++dt) { const bf16x8 af = __builtin_shufflevector(tq1[2 * dt], tq1[2 * dt + 1], 0, 1, 2, 3, 4, 5, 6, 7); o[dt] = MFMA32(af, pf[1], o[dt]); }
    }
    if (kt == 4) {
        const float inv = 1.0f / lrun;
        bf16_t* op = OP + (size_t)p * TSZ + qtok * 1024 + hd * 128 + 4 * h;
#pragma unroll
        for (int dt = 0; dt < 4; ++dt)
#pragma unroll
            for (int g = 0; g < 4; ++g) {
                u32x2 wv; wv.x = pk2_rne(o[dt][4 * g] * inv, o[dt][4 * g + 1] * inv); wv.y = pk2_rne(o[dt][4 * g + 2] * inv, o[dt][4 * g + 3] * inv);
                *(u32x2*)(op + 32 * dt + 8 * g) = wv;
            }
        if (h == 0) LSE[((size_t)p * 8 + hd) * S + qtok] = mrun + __log2f(lrun);
    }
}

__device__ __forceinline__ void attn_run_coop(int nq, int p, int hd, int res, int x0, const bf16_t* __restrict__ AQ, const bf16_t* __restrict__ AK, const bf16_t* __restrict__ AV, bf16_t* __restrict__ OP, float* __restrict__ LSE,
                                              LAS bf16_t* lbase, int lane, int w) {
    const int lg = (p == 0) ? 0 : (p == 1) ? 2 : 4, dl = 1 << lg;
    const int r = lane & 31, h = lane >> 5, lkey = lane >> 4, lch = lane & 15, rr = r - 4 * h, myrow = 4 * w + lkey;
    LAS bf16_t* const K0 = lbase; LAS bf16_t* const V0 = lbase + 4352; LAS bf16_t* const K1 = lbase + 8704; LAS bf16_t* const V1 = lbase + 8704 + 4352;
    const unsigned lanepart = (unsigned)(((4 * (lane >> 5) + ((lane & 15) >> 2)) * 136 + 16 * ((lane >> 4) & 1) + 4 * (lane & 3)) * 2);
    const unsigned vaddr0 = (unsigned)(size_t)V0 + lanepart, vaddr1 = (unsigned)(size_t)V1 + lanepart;
    u32x4 kA = (u32x4){0u, 0u, 0u, 0u}, vA = kA, kB = kA, vB = kA;
    bf16x8 qf[8]; f32x16 o[4]; float mrun = -INFINITY, lrun = 0.f; size_t qtok = 0;
#pragma unroll
    for (int j = 0; j < 8; ++j) qf[j] = (bf16x8){0, 0, 0, 0, 0, 0, 0, 0};
#pragma unroll
    for (int dt = 0; dt < 4; ++dt)
#pragma unroll
        for (int i = 0; i < 16; ++i) o[dt][i] = 0.f;
    if (ATT_TILE_VALID(0)) { const unsigned vo = ATT_VOFF(0); kA = *(const u32x4*)((const char*)AK + vo); vA = *(const u32x4*)((const char*)AV + vo); }
    if (ATT_TILE_VALID(1)) { const unsigned vo = ATT_VOFF(1); kB = *(const u32x4*)((const char*)AK + vo); vB = *(const u32x4*)((const char*)AV + vo); }
    ATT_BOOK(-1);
    if (ATT_TILE_VALID(0)) { *(LAS u32x4*)(K0 + myrow * 136 + 8 * lch) = kA; *(LAS u32x4*)(V0 + myrow * 136 + 8 * lch) = vA; }
    if (ATT_TILE_VALID(2)) { const unsigned vo = ATT_VOFF(2); kA = *(const u32x4*)((const char*)AK + vo); vA = *(const u32x4*)((const char*)AV + vo); }
    asm volatile("s_waitcnt lgkmcnt(0)" ::: "memory"); __builtin_amdgcn_s_barrier(); asm volatile("" ::: "memory");
    for (int t = 0; t < nq + 4; t += 2) {
        ATT_STEP(t, kB, vB, K1, V1, K0, vaddr0);
        ATT_STEP(t + 1, kA, vA, K0, V0, K1, vaddr1);
    }
}

struct RawA { unsigned short lf[16], vv[16]; };
__device__ __forceinline__ void hgrn_a_load(Ctx& X, int u, RawA& R) {
    const int hd = u & 7, c = u >> 3, t0 = c * 64, seg = X.tid >> 7, k = X.tid & 127;
    const bf16_t* HLF = (const bf16_t*)(X.ws + WS_PROJ) + 4 * TSZ; const bf16_t* HV = (const bf16_t*)(X.ws + WS_PROJ) + 5 * TSZ;
#pragma unroll
    for (int i = 0; i < 16; ++i) { const size_t off = (size_t)(t0 + 16 * seg + i) * 1024 + hd * 128 + k; R.lf[i] = HLF[off]; R.vv[i] = HV[off]; }
}
__device__ __forceinline__ void hgrn_a_compute(Ctx& X, int u, const RawA& R) {
    const int tid = X.tid, seg = tid >> 7, k = tid & 127, lane = X.lane, w = X.wave, r = lane & 31, h = lane >> 5;
    LAS bf16_t* KT = (LAS bf16_t*)(X.lds);
    LAS bf16_t* VT = (LAS bf16_t*)(X.lds + 18432);
    LAS float* SEG = (LAS float*)(X.lds + 36864);
    float lf[16], b[16]; float run = 0.f;
#pragma unroll
    for (int i = 0; i < 16; ++i) { lf[i] = bf2f(R.lf[i]); run += lf[i]; b[i] = run; }
    SEG[seg * 128 + k] = run;
    __syncthreads();
    float off = 0.f, tot = 0.f;
#pragma unroll
    for (int s = 0; s < 4; ++s) { const float v = SEG[s * 128 + k]; tot += v; off += (s < seg) ? v : 0.f; }
    {
        unsigned pk[8], pv[8];
#pragma unroll
        for (int i = 0; i < 8; ++i) {
            const float k0 = (1.f - __expf(lf[2 * i])) * __expf(tot - (off + b[2 * i])), k1 = (1.f - __expf(lf[2 * i + 1])) * __expf(tot - (off + b[2 * i + 1]));
            pk[i] = pk2_rne(k0, k1); pv[i] = (unsigned)R.vv[2 * i] | ((unsigned)R.vv[2 * i + 1] << 16);
        }
        *(LAS u32x4*)(KT + k * 72 + 16 * seg) = (u32x4){pk[0], pk[1], pk[2], pk[3]}; *(LAS u32x4*)(KT + k * 72 + 16 * seg + 8) = (u32x4){pk[4], pk[5], pk[6], pk[7]};
        *(LAS u32x4*)(VT + k * 72 + 16 * seg) = (u32x4){pv[0], pv[1], pv[2], pv[3]}; *(LAS u32x4*)(VT + k * 72 + 16 * seg + 8) = (u32x4){pv[4], pv[5], pv[6], pv[7]};
    }
    if (seg == 0) ((float*)(X.ws + WS_DBUF))[(size_t)u * 128 + k] = __expf(tot);
    __syncthreads();
    const int vt = w >> 1, kt2 = 2 * (w & 1);
    f32x16 acc[2];
#pragma unroll
    for (int e = 0; e < 2; ++e)
#pragma unroll
        for (int i = 0; i < 16; ++i) acc[e][i] = 0.f;
#pragma unroll
    for (int ks = 0; ks < 4; ++ks) {
        const bf16x8 bfr = *(const LAS bf16x8*)(VT + (32 * vt + r) * 72 + 16 * ks + 8 * h);
#pragma unroll
        for (int e = 0; e < 2; ++e) { const bf16x8 af = *(const LAS bf16x8*)(KT + (32 * (kt2 + e) + r) * 72 + 16 * ks + 8 * h); acc[e] = MFMA32(af, bfr, acc[e]); }
    }
    bf16_t* P = (bf16_t*)X.out + (size_t)u * 16384;
#pragma unroll
    for (int e = 0; e < 2; ++e)
#pragma unroll
        for (int g = 0; g < 4; ++g) {
            { u32x2 pw; pw.x = pk2_rne(acc[e][4 * g], acc[e][4 * g + 1]); pw.y = pk2_rne(acc[e][4 * g + 2], acc[e][4 * g + 3]);
              *(u32x2*)(P + (32 * vt + r) * 128 + 32 * (kt2 + e) + 8 * g + 4 * h) = pw; }
        }
    __syncthreads();
}

struct RawC { unsigned short lf[16], q[16], vv[16]; };
__device__ __forceinline__ void hgrn_c_load(Ctx& X, int u, RawC& R) {
    const int hd = u & 7, c = u >> 3, t0 = c * 64, seg = X.tid >> 7, k = X.tid & 127;
    const bf16_t* PR = (const bf16_t*)(X.ws + WS_PROJ);
    const bf16_t* HQ = PR + 3 * TSZ; const bf16_t* HLF = PR + 4 * TSZ; const bf16_t* HV = PR + 5 * TSZ;
#pragma unroll
    for (int i = 0; i < 16; ++i) { const size_t off = (size_t)(t0 + 16 * seg + i) * 1024 + hd * 128 + k; R.lf[i] = HLF[off]; R.q[i] = HQ[off]; R.vv[i] = HV[off]; }
}
__device__ __forceinline__ void hgrn_c_compute(Ctx& X, int u, const RawC& R) {
    const int hd = u & 7, c = u >> 3, t0 = c * 64;
    const int tid = X.tid, seg = tid >> 7, k = tid & 127, lane = X.lane, w = X.wave, r = lane & 31, h = lane >> 5;
    LAS bf16_t* QH = (LAS bf16_t*)(X.lds);
    LAS bf16_t* QT = (LAS bf16_t*)(X.lds + 17408);
    LAS bf16_t* KT2 = (LAS bf16_t*)(X.lds + 34816);
    LAS bf16_t* VT = (LAS bf16_t*)(X.lds + 52224);
    LAS bf16_t* AM = (LAS bf16_t*)(X.lds + 70656);
    LAS float* OF = (LAS float*)(X.lds + 79872);
    LAS float* SEG = (LAS float*)(X.lds + 113664);
    const bf16_t* HG = (const bf16_t*)(X.ws + WS_PROJ) + 6 * TSZ;
    const int tt2 = w & 1, vt2 = w >> 1;
    bf16x8 sfr[8];
    {
        const bf16_t* sb = (const bf16_t*)(X.ws + WS_SBUF) + (size_t)u * 16384 + (32 * vt2 + r) * 128 + 8 * h;
#pragma unroll
        for (int kk = 0; kk < 8; ++kk) sfr[kk] = *(const bf16x8*)(sb + 16 * kk);
    }
    const int tn = tid >> 3, sub = tid & 7;
    const u32x4 g0 = *(const u32x4*)(HG + (size_t)(t0 + tn) * 1024 + hd * 128 + 16 * sub), g1 = *(const u32x4*)(HG + (size_t)(t0 + tn) * 1024 + hd * 128 + 16 * sub + 8);
    {
        float lf[16], b[16]; float run = 0.f;
#pragma unroll
        for (int i = 0; i < 16; ++i) { lf[i] = bf2f(R.lf[i]); run += lf[i]; b[i] = run; }
        SEG[seg * 128 + k] = run;
        __syncthreads();
        float off = 0.f;
#pragma unroll
        for (int s = 0; s < 4; ++s) { const float v = SEG[s * 128 + k]; off += (s < seg) ? v : 0.f; }
        const float bmid = SEG[k] + SEG[128 + k];
        unsigned pv[8];
#pragma unroll
        for (int i = 0; i < 16; ++i) {
            const float bt = off + b[i]; const int t = 16 * seg + i; const float q = bf2f(R.q[i]);
            const unsigned qh = pk2_rne(q * __expf(bt), q * __expf(bt - bmid));
            const unsigned kk = pk2_rne((1.f - __expf(lf[i])) * __expf(bmid - bt), 0.f);
            QH[t * 136 + k] = (bf16_t)(qh & 0xffffu); QT[t * 136 + k] = (bf16_t)(qh >> 16); KT2[t * 136 + k] = (bf16_t)(kk & 0xffffu);
        }
#pragma unroll
        for (int i = 0; i < 8; ++i) pv[i] = (unsigned)R.vv[2 * i] | ((unsigned)R.vv[2 * i + 1] << 16);
        *(LAS u32x4*)(VT + k * 72 + 16 * seg) = (u32x4){pv[0], pv[1], pv[2], pv[3]}; *(LAS u32x4*)(VT + k * 72 + 16 * seg + 8) = (u32x4){pv[4], pv[5], pv[6], pv[7]};
    }
    __syncthreads();
    if (w < 4) {
        const int st = w >> 1, tt = w & 1;
        f32x16 acc;
#pragma unroll
        for (int i = 0; i < 16; ++i) acc[i] = 0.f;
        if (!(st == 1 && tt == 0)) {
#pragma unroll
            for (int kk = 0; kk < 8; ++kk) {
                const bf16x8 af = *(const LAS bf16x8*)(KT2 + (32 * st + r) * 136 + 16 * kk + 8 * h);
                const bf16x8 bfr = *(const LAS bf16x8*)(QT + (32 * tt + r) * 136 + 16 * kk + 8 * h);
                acc = MFMA32(af, bfr, acc);
            }
        }
        const int t = 32 * tt + r;
#pragma unroll
        for (int g = 0; g < 4; ++g) {
            float v[4];
#pragma unroll
            for (int e = 0; e < 4; ++e) { const int s = 32 * st + 8 * g + 4 * h + e; v[e] = (s <= t) ? acc[4 * g + e] : 0.f; }
            u32x2 pw; pw.x = pk2_rne(v[0], v[1]); pw.y = pk2_rne(v[2], v[3]);
            *(LAS u32x2*)(AM + t * 72 + 32 * st + 8 * g + 4 * h) = pw;
        }
    }
    __syncthreads();
    {
        f32x16 acc;
#pragma unroll
        for (int i = 0; i < 16; ++i) acc[i] = 0.f;
#pragma unroll
        for (int kk = 0; kk < 8; ++kk) {
            const bf16x8 af = *(const LAS bf16x8*)(QH + (32 * tt2 + r) * 136 + 16 * kk + 8 * h);
            acc = MFMA32(af, sfr[kk], acc);
        }
#pragma unroll
        for (int ks = 0; ks < 4; ++ks) {
            const bf16x8 af = *(const LAS bf16x8*)(AM + (32 * tt2 + r) * 72 + 16 * ks + 8 * h);
            const bf16x8 bfr = *(const LAS bf16x8*)(VT + (32 * vt2 + r) * 72 + 16 * ks + 8 * h);
            acc = MFMA32(af, bfr, acc);
        }
#pragma unroll
        for (int i = 0; i < 16; ++i) OF[(32 * tt2 + crow(i, h)) * 132 + 32 * vt2 + r] = acc[i];
    }
    __syncthreads();
    {
        float ov[16]; float ss = 0.f;
#pragma unroll
        for (int e = 0; e < 4; ++e) { const f32x4 q4 = *(const LAS f32x4*)(OF + tn * 132 + 16 * sub + 4 * e); ov[4 * e] = q4[0]; ov[4 * e + 1] = q4[1]; ov[4 * e + 2] = q4[2]; ov[4 * e + 3] = q4[3]; }
#pragma unroll
        for (int e = 0; e < 16; ++e) ss += ov[e] * ov[e];
        ss += __shfl_xor(ss, 1); ss += __shfl_xor(ss, 2); ss += __shfl_xor(ss, 4);
        const float rinv = rsqrtf(ss * (1.f / 128.f) + EPS);
        const unsigned gw[8] = {g0.x, g0.y, g0.z, g0.w, g1.x, g1.y, g1.z, g1.w};
        unsigned pw[8];
#pragma unroll
        for (int e = 0; e < 8; ++e) {
            const float w0 = X.gnorm_w[16 * sub + 2 * e], w1 = X.gnorm_w[16 * sub + 2 * e + 1];
            pw[e] = pk2_rne(ov[2 * e] * rinv * w0 * bflo(gw[e]), ov[2 * e + 1] * rinv * w1 * bfhi(gw[e]));
        }
        bf16_t* yp = (bf16_t*)(X.ws + WS_H) + (size_t)(t0 + tn) * D + 1024 + hd * 128 + 16 * sub;
        *(u32x4*)(yp) = (u32x4){pw[0], pw[1], pw[2], pw[3]}; *(u32x4*)(yp + 8) = (u32x4){pw[4], pw[5], pw[6], pw[7]};
    }
    __syncthreads();
}

__device__ __forceinline__ void phase_scan_combine(Ctx& X) {
    const int gt = blockIdx.x * 512 + X.tid, NT = X.G * 512;
    const bf16_t* P = (const bf16_t*)X.out; const float* DB = (const float*)(X.ws + WS_DBUF); bf16_t* SB = (bf16_t*)(X.ws + WS_SBUF);
    for (int e = gt; e < 131072; e += NT) {
        const int hd = e >> 14, k = e & 127;
        float st = 0.f;
        for (int c0 = 0; c0 < 256; c0 += 8) {
            float pv[8], dv[8];
#pragma unroll
            for (int j = 0; j < 8; ++j) { pv[j] = bf2f(P[(size_t)(c0 + j) * 131072 + e]); dv[j] = DB[((c0 + j) * 8 + hd) * 128 + k]; }
#pragma unroll
            for (int j = 0; j < 8; ++j) { SB[(size_t)(c0 + j) * 131072 + e] = (bf16_t)(pk2_rne(st, 0.f) & 0xffffu); st = dv[j] * st + pv[j]; }
        }
    }
    const bf16_t* OP = (const bf16_t*)(X.ws + WS_OP); const float* LSE = (const float*)(X.ws + WS_LSE); bf16_t* Y = (bf16_t*)(X.ws + WS_H);
    for (int e = gt; e < S * 128; e += NT) {
        const int t = e >> 7, cg8 = e & 127, hd = cg8 >> 4;
        const float l0 = LSE[(size_t)(0 * 8 + hd) * S + t], l1 = LSE[(size_t)(1 * 8 + hd) * S + t], l2 = LSE[(size_t)(2 * 8 + hd) * S + t];
        const float mx = fmaxf(l0, fmaxf(l1, l2));
        float w0 = __builtin_amdgcn_exp2f(l0 - mx), w1 = __builtin_amdgcn_exp2f(l1 - mx), w2 = __builtin_amdgcn_exp2f(l2 - mx);
        const float inv = 1.f / (w0 + w1 + w2); w0 *= inv; w1 *= inv; w2 *= inv;
        const size_t off = (size_t)t * 1024 + cg8 * 8;
        const u32x4 a = *(const u32x4*)(OP + off), b = *(const u32x4*)(OP + TSZ + off), cc = *(const u32x4*)(OP + 2 * TSZ + off);
        u32x4 o;
#pragma unroll
        for (int j = 0; j < 4; ++j) o[j] = pk2_rne(w0 * bflo(a[j]) + w1 * bflo(b[j]) + w2 * bflo(cc[j]), w0 * bfhi(a[j]) + w1 * bfhi(b[j]) + w2 * bfhi(cc[j]));
        *(u32x4*)(Y + (size_t)t * D + cg8 * 8) = o;
    }
}

__device__ __forceinline__ void phase_fixup(Ctx& X) {
    const int gt = blockIdx.x * 512 + X.tid, NT = X.G * 512;
    const float* HALO = (const float*)(X.ws + WS_HALO); const float* HEAD = (const float*)(X.ws + WS_HEAD); bf16_t* ACT = (bf16_t*)(X.ws + WS_ACT);
    for (int it = gt; it < 64 * DFF; it += NT) {
        const int pm = it / DFF, j = it - pm * DFF, ig = 256 * (j >> 7) + (j & 127), iu = ig + 128;
        float gm2 = 0.f, gm1 = 0.f, um2 = 0.f, um1 = 0.f;
        if (pm > 0) { const float* hp = HALO + (size_t)(pm - 1) * 2 * UPW; gm2 = hp[ig]; gm1 = hp[UPW + ig]; um2 = hp[iu]; um1 = hp[UPW + iu]; }
        const float* hd = HEAD + (size_t)pm * 2 * UPW;
        const float g0 = hd[ig], g1 = hd[UPW + ig], u0 = hd[iu], u1 = hd[UPW + iu];
        const float wg0 = X.conv_w[j], wg1 = X.conv_w[UPW + j], wg2 = X.conv_w[2 * UPW + j], bg = X.conv_b[j];
        const float wu0 = X.conv_w[DFF + j], wu1 = X.conv_w[UPW + DFF + j], wu2 = X.conv_w[2 * UPW + DFF + j], bu = X.conv_b[DFF + j];
        const float yg0 = wg0 * gm2 + wg1 * gm1 + wg2 * g0 + bg, yu0 = wu0 * um2 + wu1 * um1 + wu2 * u0 + bu;
        const float yg1 = wg0 * gm1 + wg1 * g0 + wg2 * g1 + bg, yu1 = wu0 * um1 + wu1 * u0 + wu2 * u1 + bu;
        ACT[(size_t)(256 * pm) * DFF + j] = (bf16_t)(pk2_rne(fast_silu(yg0) * yu0, 0.f) & 0xffffu);
        ACT[(size_t)(256 * pm + 1) * DFF + j] = (bf16_t)(pk2_rne(fast_silu(yg1) * yu1, 0.f) & 0xffffu);
    }
}

#define XB_TMO      128
#define XB_XCNT(j)  (256  + 64 * (j))
#define XB_XSUB(j)  (1280 + 64 * (j))
#define XB_XGEN(j)  (2304 + 64 * (j))
#define XB_TOP      3328
#define XB_TOPGEN   3392
#define XCD_BAR_WORDS 3456
#define XB_SPIN_CAP (1u << 20)
__device__ __forceinline__ unsigned xb_ld(unsigned* p)              { return __hip_atomic_load(p, __ATOMIC_RELAXED, __HIP_MEMORY_SCOPE_AGENT); }
__device__ __forceinline__ unsigned xb_add(unsigned* p, unsigned v) { return __hip_atomic_fetch_add(p, v, __ATOMIC_RELAXED, __HIP_MEMORY_SCOPE_AGENT); }
__device__ __forceinline__ unsigned xb_xcc_id() { return (unsigned)__builtin_amdgcn_s_getreg((3 << 11) | 20) & 0xFu; }
#define XB_SPIN(cond, bar) do { unsigned _sp = 0; while (cond) { __builtin_amdgcn_s_sleep(1); \
    if ((++_sp & 255u) == 0u) { if (xb_ld(&(bar)[XB_TMO])) break; if (_sp > XB_SPIN_CAP) { atomicAdd(&(bar)[XB_TMO], 1u); break; } } } } while (0)
struct XcdBarrier { unsigned* bar; unsigned x; volatile LAS unsigned* st; };
__device__ __forceinline__ XcdBarrier xcd_barrier_post(unsigned* bar, volatile LAS unsigned* st) {
    XcdBarrier b; b.bar = bar; b.x = xb_xcc_id(); b.st = st;
    if (threadIdx.x == 0) (void)xb_add(&bar[XB_XCNT(b.x)], 1u);
    return b;
}
__device__ __forceinline__ void xcd_barrier_complete(unsigned* bar, unsigned x, unsigned& nloc, unsigned& nx) {
    const unsigned G = gridDim.x * gridDim.y * gridDim.z;
    unsigned sum, cnt, mine, sp = 0u;
    for (;;) {
        sum = 0u; cnt = 0u; mine = 0u;
#pragma unroll
        for (unsigned j = 0; j < 16; ++j) { const unsigned c = xb_ld(&bar[XB_XCNT(j)]); sum += c; cnt += (c > 0u) ? 1u : 0u; mine = (j == x) ? c : mine; }
        if (sum == G) break;
        __builtin_amdgcn_s_sleep(1);
        if ((++sp & 255u) == 0u) { if (xb_ld(&bar[XB_TMO])) break; if (sp > XB_SPIN_CAP) { atomicAdd(&bar[XB_TMO], 1u); break; } }
    }
    nloc = mine > 0u ? mine : 1u; nx = cnt > 0u ? cnt : 1u;
}
__device__ __forceinline__ void xcd_barrier(const XcdBarrier& b) {
    asm volatile("s_waitcnt vmcnt(0)" ::: "memory");
    __syncthreads();
    if (threadIdx.x == 0) {
        unsigned* bar = b.bar;
        __builtin_amdgcn_s_waitcnt(0);
        unsigned nloc = b.st[0], nx = b.st[1];
        if (nloc == 0u) { xcd_barrier_complete(bar, b.x, nloc, nx); b.st[0] = nloc; b.st[1] = nx; }
        const unsigned old = xb_add(&bar[XB_XSUB(b.x)], 1u);
        const unsigned gen = old / nloc;
        if (old + 1u == (gen + 1u) * nloc) {
            __builtin_amdgcn_fence(__ATOMIC_RELEASE, "agent");
            asm volatile("s_waitcnt vmcnt(0)" ::: "memory");
            const unsigned og = xb_add(&bar[XB_TOP], 1u);
            const unsigned tg = og / nx;
            if (og + 1u == (tg + 1u) * nx) xb_add(&bar[XB_TOPGEN], 1u);
            else XB_SPIN(xb_ld(&bar[XB_TOPGEN]) == tg, bar);
            __builtin_amdgcn_fence(__ATOMIC_ACQUIRE, "agent");
            xb_add(&bar[XB_XGEN(b.x)], 1u);
            asm volatile("s_waitcnt vmcnt(0)" ::: "memory");
        } else {
            XB_SPIN(xb_ld(&bar[XB_XGEN(b.x)]) == gen, bar);
            __builtin_amdgcn_fence(__ATOMIC_ACQUIRE, "agent");
            asm volatile("s_waitcnt vmcnt(0)" ::: "memory");
        }
    }
    __syncthreads();
}

struct Args { const void* in[16]; float* out; unsigned char* ws; int ph_lo, ph_hi; };

__global__ void __launch_bounds__(512, 2) fwd_mega(Args a) {
    extern __shared__ __attribute__((aligned(16))) unsigned char lds_raw[];
    cg::grid_group grid = cg::this_grid();
    Ctx X;
    X.lds = (LAS unsigned char*)lds_raw; X.ws = a.ws; X.out = a.out;
    X.x = (const float*)a.in[0]; X.c = (const float*)a.in[1]; X.pos = (const int*)a.in[2]; X.w_ada = (const float*)a.in[3]; X.b_ada = (const float*)a.in[4];
    X.norm1_w = (const float*)a.in[5]; X.w_in = (const float*)a.in[6]; X.lb_logits = (const float*)a.in[7]; X.gnorm_w = (const float*)a.in[8]; X.w_out = (const float*)a.in[9];
    X.norm2_w = (const float*)a.in[10]; X.w_up = (const float*)a.in[11]; X.conv_w = (const float*)a.in[12]; X.conv_b = (const float*)a.in[13]; X.w_down = (const float*)a.in[14]; X.final_w = (const float*)a.in[15];
    X.tid = threadIdx.x; X.lane = X.tid & 63; X.wave = __builtin_amdgcn_readfirstlane(X.tid >> 6); X.G = gridDim.x;
    X.gw = blockIdx.x * NWAVES + X.wave; X.NGW = X.G * NWAVES;
    const int lo = a.ph_lo, hi = a.ph_hi;
    const float* mod = (const float*)(X.ws + WS_CTL);
    bf16_t* PROJ = (bf16_t*)(X.ws + WS_PROJ);
#define IN(k) (lo <= (k) && (k) < hi)
    volatile LAS unsigned* bst = (volatile LAS unsigned*)(X.lds + LDS_BYTES - 64);
    if (X.tid < 16) bst[X.tid] = 0u;
    __syncthreads();
    XcdBarrier xbar; xbar.bar = (unsigned*)(X.ws + WS_BAR); xbar.x = 0; xbar.st = bst;
    if (hi - lo > 1) xbar = xcd_barrier_post((unsigned*)(X.ws + WS_BAR), bst);
    if (lo < 0) grid.sync();
#define SEAM(k) do { if (IN(k) && IN((k) + 1)) xcd_barrier(xbar); } while (0)

    if (IN(0)) phase_prologue(X);
    SEAM(0);
    if (IN(1)) rows_norm_mod(X, X.x, nullptr, nullptr, X.norm1_w, mod + 2048, mod + 0, (bf16_t*)(X.ws + WS_H), true);
    SEAM(1);
    if (IN(2)) {
        pg8::Gemm g{(const bf16_t*)(X.ws + WS_H), (const bf16_t*)(X.ws + WS_WIN), S, INW, D, D}; pg8::StaticOrder so; so.init(S, INW, X.G, (int)blockIdx.x);
        EpiProj E{PROJ, (const float*)(X.ws + WS_CS), X.lb_logits};
        pg8::gemm_phase<EpiProj, pg8::StaticOrder>(X.lds, g, so, E);
    }
    SEAM(2);
    if (IN(3)) {
        {
            RawA cur; hgrn_a_load(X, blockIdx.x, cur);
            for (int u = blockIdx.x; u < 2048; u += X.G) { RawA nxt = cur; if (u + X.G < 2048) hgrn_a_load(X, u + X.G, nxt); hgrn_a_compute(X, u, cur); cur = nxt; }
        }
        LAS bf16_t* kl = (LAS bf16_t*)(X.lds + X.wave * 17408); LAS bf16_t* vl = kl + 4352;
        if (X.G == 256) {
            const int hd = blockIdx.x & 7, jx = blockIdx.x >> 3;
            bf16_t* OPp = (bf16_t*)(X.ws + WS_OP); float* LSEp = (float*)(X.ws + WS_LSE);
            {
                const int p = jx >> 4, q = jx & 15;
                attn_run_coop(32, p, hd, p ? (q >> 2) : 0, p ? 32 * (q & 3) : 32 * q, PROJ, PROJ + TSZ, PROJ + 2 * TSZ, OPp, LSEp, (LAS bf16_t*)X.lds, X.lane, X.wave);
            }
            attn_run_coop(16, 2, hd, jx >> 1, 16 * (jx & 1), PROJ, PROJ + TSZ, PROJ + 2 * TSZ, OPp, LSEp, (LAS bf16_t*)X.lds, X.lane, X.wave);
        } else {
            const int per = (12288 + X.G - 1) / X.G;
            for (int i = X.wave; i < per; i += NWAVES) {
                const int id = blockIdx.x * per + i;
                if (id < 12288) attn_item(id, PROJ, PROJ + TSZ, PROJ + 2 * TSZ, (bf16_t*)(X.ws + WS_OP), (float*)(X.ws + WS_LSE), kl, vl, X.lane);
            }
        }
    }
    SEAM(3);
    if (IN(4)) phase_scan_combine(X);
    SEAM(4);
    if (IN(5)) {
        RawC cur; hgrn_c_load(X, blockIdx.x, cur);
        for (int u = blockIdx.x; u < 2048; u += X.G) { RawC nxt = cur; if (u + X.G < 2048) hgrn_c_load(X, u + X.G, nxt); hgrn_c_compute(X, u, cur); cur = nxt; }
    }
    SEAM(5);
    if (IN(6)) {
        pg8::Gemm g{(const bf16_t*)(X.ws + WS_H), (const bf16_t*)(X.ws + WS_WOUT), S, D, D, D}; pg8::StaticOrder so; so.init(S, D, X.G, (int)blockIdx.x);
        EpiDelta E{(bf16_t*)(X.ws + WS_D1), mod + 4096};
        pg8::gemm_phase<EpiDelta, pg8::StaticOrder>(X.lds, g, so, E);
    }
    SEAM(6);
    if (IN(7)) rows_norm_mod(X, X.x, (const bf16_t*)(X.ws + WS_D1), nullptr, X.norm2_w, mod + 8192, mod + 6144, (bf16_t*)(X.ws + WS_H2), false);
    SEAM(7);
    if (IN(8)) {
        pg8::Gemm g{(const bf16_t*)(X.ws + WS_H2), (const bf16_t*)(X.ws + WS_WUP), S, UPW, D, D}; pg8::StaticOrder so; so.init(S, UPW, X.G, (int)blockIdx.x);
        EpiUpConv E{(bf16_t*)(X.ws + WS_ACT), (float*)(X.ws + WS_HEAD), (float*)(X.ws + WS_HALO), X.conv_w, X.conv_b, (LAS float*)(X.lds + 131072)};
        pg8::gemm_phase<EpiUpConv, pg8::StaticOrder>(X.lds, g, so, E);
    }
    SEAM(8);
    if (IN(9)) phase_fixup(X);
    SEAM(9);
    if (IN(10)) {
        pg8::Gemm g{(const bf16_t*)(X.ws + WS_ACT), (const bf16_t*)(X.ws + WS_WDOWN), S, D, DFF, DFF}; pg8::StaticOrder so; so.init(S, D, X.G, (int)blockIdx.x);
        EpiDelta E{(bf16_t*)(X.ws + WS_D2), mod + 10240};
        pg8::gemm_phase<EpiDelta, pg8::StaticOrder>(X.lds, g, so, E);
    }
    SEAM(10);
    if (IN(11)) rows_final(X);
#undef IN
#undef SEAM
}

extern "C" void kernel_launch(void* const* d_in, const int* in_sizes, int n_in, void* d_out, int out_size, void* d_ws, size_t ws_size, hipStream_t stream) {
    static int grid = 0;
    if (grid == 0) {
        if (n_in != 16 || out_size != S * D || ws_size < WS_NEED) { fprintf(stderr, "kernel_launch: unexpected shapes (n_in %d, out %d, ws %zu < %zu)\n", n_in, out_size, ws_size, (size_t)WS_NEED); grid = -1; return; }
        int dev = 0, cus = 0, per_cu = 0;
        (void)hipGetDevice(&dev); (void)hipDeviceGetAttribute(&cus, hipDeviceAttributeMultiprocessorCount, dev);
        if (hipFuncSetAttribute((const void*)fwd_mega, hipFuncAttributeMaxDynamicSharedMemorySize, LDS_BYTES) != hipSuccess) { fprintf(stderr, "kernel_launch: hipFuncSetAttribute failed\n"); grid = -1; return; }
        if (hipOccupancyMaxActiveBlocksPerMultiprocessor(&per_cu, (const void*)fwd_mega, 512, LDS_BYTES) != hipSuccess || per_cu < 1) { fprintf(stderr, "kernel_launch: occupancy query says %d\n", per_cu); per_cu = 1; }
        (void)hipGetLastError();
        grid = cus * 1;
        if (grid <= 0) grid = 256;
    }
    if (grid < 0) return;
    (void)hipMemsetAsync((char*)d_ws + WS_CTL, 0, 131072, stream);
    Args a{};
    for (int i = 0; i < 16; ++i) a.in[i] = d_in[i];
    a.out = (float*)d_out; a.ws = (unsigned char*)d_ws;
#if MK_SINGLE
    a.ph_lo = 0; a.ph_hi = NPHASE;
    void* args[] = {&a};
    hipError_t e = hipLaunchCooperativeKernel((const void*)fwd_mega, dim3(grid), dim3(512), args, LDS_BYTES, stream);
    if (e != hipSuccess) fprintf(stderr, "cooperative launch failed: %s (grid %d)\n", hipGetErrorString(e), grid);
#else
    for (int p = 0; p < NPHASE; ++p) { a.ph_lo = p; a.ph_hi = p + 1; hipLaunchKernelGGL(fwd_mega, dim3(grid), dim3(512), LDS_BYTES, stream, a);
#ifdef PROBE_DUP_MASK
        if ((PROBE_DUP_MASK >> p) & 1) hipLaunchKernelGGL(fwd_mega, dim3(grid), dim3(512), LDS_BYTES, stream, a);
#endif
    }
#endif
}
```

```cpp
#include <hip/hip_runtime.h>
#include <hip/hip_cooperative_groups.h>
#include <cstdio>
#include <cstdint>
namespace cg = cooperative_groups;

#define LAS __attribute__((address_space(3)))
typedef unsigned short bf16_t;
typedef short bf16x8 __attribute__((ext_vector_type(8)));
typedef float f32x4 __attribute__((ext_vector_type(4)));
typedef float f32x16 __attribute__((ext_vector_type(16)));
typedef unsigned u32x4 __attribute__((ext_vector_type(4)));
typedef unsigned u32x2 __attribute__((ext_vector_type(2)));

#ifndef MK_SINGLE
#define MK_SINGLE 1
#endif

constexpr int S = 16384, D = 2048, INW = 7168, DFF = 5632, UPW = 11264, NMOD = 12288;
constexpr float EPS = 1e-6f;
constexpr int NPHASE = 12;
constexpr int NWAVES = 8;
constexpr int LDS_BYTES = 160 * 1024;

constexpr size_t MiB = 1u << 20;
constexpr size_t WS_CTL = 0;
constexpr size_t WS_WDOWN = 1 * MiB;
constexpr size_t WS_WUP = 23 * MiB;
constexpr size_t WS_CS = 67 * MiB;
constexpr size_t WS_LSE = 69 * MiB;
constexpr size_t WS_DBUF = 71 * MiB;
constexpr size_t WS_HALO = 72 * MiB;
constexpr size_t WS_HEAD = WS_HALO + 5767168;
constexpr size_t WS_BAR = 65536;
constexpr size_t WS_WIN = 83 * MiB;
constexpr size_t WS_WOUT = 111 * MiB;
constexpr size_t WS_H = 119 * MiB;
constexpr size_t WS_PROJ = 183 * MiB;
constexpr size_t WS_OP = 407 * MiB;
constexpr size_t WS_SBUF = WS_PROJ;
constexpr size_t WS_H2 = 83 * MiB;
constexpr size_t WS_ACT = 147 * MiB;
constexpr size_t WS_D1 = 387 * MiB;
constexpr size_t WS_D2 = 323 * MiB;
constexpr size_t WS_NEED = 503 * MiB;
constexpr size_t TSZ = (size_t)S * 1024;

__device__ __forceinline__ unsigned cvt_pk_bf16(float lo, float hi) { unsigned r; asm volatile("v_cvt_pk_bf16_f32 %0, %1, %2" : "=v"(r) : "v"(lo), "v"(hi)); return r; }
typedef __bf16 bf16x2_t __attribute__((ext_vector_type(2)));
typedef float f32x2_t __attribute__((ext_vector_type(2)));
__device__ __forceinline__ unsigned pk2_rne(float lo, float hi) { const f32x2_t f = {lo, hi}; return __builtin_bit_cast(unsigned, __builtin_convertvector(f, bf16x2_t)); }
__device__ __forceinline__ float bf2f(unsigned short b) { return __uint_as_float(((unsigned)b) << 16); }
__device__ __forceinline__ float bflo(unsigned w) { return __uint_as_float(w << 16); }
__device__ __forceinline__ float bfhi(unsigned w) { return __uint_as_float(w & 0xffff0000u); }
__device__ __forceinline__ float wave_sum(float v) {
#pragma unroll
    for (int o = 1; o < 64; o <<= 1) v += __shfl_xor(v, o);
    return v;
}
__device__ __forceinline__ float fast_sigmoid(float x) { return __builtin_amdgcn_rcpf(1.0f + __expf(-x)); }
__device__ __forceinline__ float fast_silu(float x) { return x * fast_sigmoid(x); }
__device__ __forceinline__ int crow(int reg, int h) { return (reg & 3) + 8 * (reg >> 2) + 4 * h; }
#define MFMA32(a, b, c) __builtin_amdgcn_mfma_f32_32x32x16_bf16((a), (b), (c), 0, 0, 0)

namespace pg8 {
constexpr int BM = 256, BK = 64, HALF = 128, HTB = HALF * BK * 2, STAGE_BYTES = 8 * HTB, NXCD = 8, WGM = 4;
__host__ __device__ __forceinline__ int lds_byte(int r, int c) { const int st = (r >> 4) * 2 + (c >> 5), rr = r & 15, cc = c & 31, ob = rr * 64 + cc * 2; return st * 1024 + (ob ^ (((ob >> 9) & 1) << 5)); }
__host__ __device__ __forceinline__ void stage_rc(int b, int& R, int& C) { const int st = b / 1024, sb = b % 1024, swz = sb ^ (((sb >> 9) & 1) << 5); R = (st >> 1) * 16 + swz / 64; C = (st & 1) * 32 + (swz % 64) / 2; }
__host__ __device__ __forceinline__ int perm32(int rho) { const int n = rho >> 4, i = rho & 15; return 8 * (i >> 2) + 4 * n + (i & 3); }

struct Unit { int pm, pn; };
struct Gemm { const bf16_t* A; const bf16_t* Bt; int M, N, K, lda; };

struct StaticOrder {
    int nM, nN, nwg, G, c;
    __host__ __device__ void init(int M, int N, int G_, int c_) { nM = M / BM; nN = N / BM; nwg = nM * nN; G = G_; c = c_; }
    __host__ __device__ bool next(int i, Unit& u) const {
        const long L = (long)i * G + c; if (L >= nwg) return false;
        int wgid = (int)L; { const int q = nwg / NXCD, r = nwg % NXCD, xcd = wgid % NXCD, off = wgid / NXCD; wgid = (xcd < r ? xcd * (q + 1) : r * (q + 1) + (xcd - r) * q) + off; }
        const int nig = WGM * nN, gid = wgid / nig, fm = gid * WGM, gsz = (nM - fm) < WGM ? (nM - fm) : WGM;
        u.pm = fm + ((wgid % nig) % gsz); u.pn = (wgid % nig) / gsz; return true;
    }
};

template <class Epi, class Sched>
__device__ __forceinline__ void gemm_phase(LAS unsigned char* lds, const Gemm g, const Sched& S, const Epi& E) {
    const int tid = threadIdx.x, wid = __builtin_amdgcn_readfirstlane(tid >> 6), lane = tid & 63, wr = wid >> 2, wc = wid & 3, fr = lane & 15, fq = lane >> 4;
    const int K = g.K, nt = K / BK, lda = g.lda;
    unsigned voffA[2], voffB[2];
#pragma unroll
    for (int i = 0; i < 2; ++i) { int R, C; stage_rc(tid * 16 + i * 8192, R, C); const int Rb = Epi::PERM ? ((R & ~31) + perm32(R & 31)) : R;
        voffA[i] = (unsigned)(R * lda + C) * 2u; voffB[i] = (unsigned)(Rb * K + C) * 2u; }
    const size_t kstep = (size_t)(BK * 2);
    const size_t hstepA = (size_t)HALF * lda * 2, hstepB = (size_t)HALF * K * 2;
    const size_t tstepA = 2 * hstepA, tstepB = 2 * hstepB;
    const unsigned ldsw = (unsigned)wid * 1024u;
    const int aoff = lds_byte(wr * 64 + fr, fq * 8), boff = lds_byte(wc * 32 + fr, fq * 8);
#define PG8_SA(b, h) (((b) * 2 + (h)) * HTB)
#define PG8_SB(b, h) ((4 + (b) * 2 + (h)) * HTB)
#define PG8_STAGE(bufoff, gbase, voff) do { _Pragma("unroll") for (int _i = 0; _i < 2; ++_i) \
        __builtin_amdgcn_global_load_lds((const unsigned*)((const char*)(gbase) + (voff)[_i]), (LAS unsigned*)(lds + (bufoff) + ldsw + _i * 8192), 16, 0, 0); } while (0)
#define PG8_LDA(dst, b, h) do { _Pragma("unroll") for (int m = 0; m < 4; ++m) _Pragma("unroll") for (int k = 0; k < 2; ++k) dst[m][k] = *(const LAS bf16x8*)(lds + PG8_SA(b, h) + aoff + m * 2048 + k * 1024); } while (0)
#define PG8_LDB(dst, b, h) do { _Pragma("unroll") for (int n = 0; n < 2; ++n) _Pragma("unroll") for (int k = 0; k < 2; ++k) dst[n][k] = *(const LAS bf16x8*)(lds + PG8_SB(b, h) + boff + n * 2048 + k * 1024); } while (0)
#define PG8_MMA(ai, bj, At, Bt) do { __builtin_amdgcn_s_setprio(1); _Pragma("unroll") for (int m = 0; m < 4; ++m) _Pragma("unroll") for (int n = 0; n < 2; ++n) _Pragma("unroll") for (int k = 0; k < 2; ++k) \
        acc[ai][bj][m][n] = __builtin_amdgcn_mfma_f32_16x16x32_bf16(Bt[n][k], At[m][k], acc[ai][bj][m][n], 0, 0, 0); __builtin_amdgcn_s_setprio(0); } while (0)
#define PG8_WAIT_V(n) asm volatile("s_waitcnt vmcnt(" #n ")" ::: "memory")
#define PG8_WAIT_L(n) asm volatile("s_waitcnt lgkmcnt(" #n ")" ::: "memory")
#define PG8_BAR __builtin_amdgcn_s_barrier()
#define PG8_SCHED __builtin_amdgcn_sched_barrier(0)
    Unit cur, nxt; int ui = 0;
    if (!S.next(0, cur)) return;
    f32x4 acc[2][2][4][2];
#pragma unroll
    for (int a = 0; a < 2; ++a)
#pragma unroll
        for (int b = 0; b < 2; ++b)
#pragma unroll
            for (int m = 0; m < 4; ++m)
#pragma unroll
                for (int n = 0; n < 2; ++n) acc[a][b][m][n] = (f32x4){0.f, 0.f, 0.f, 0.f};
    bf16x8 At[4][2], B0[2][2], B1[2][2];
    const char* cA = (const char*)g.A + (size_t)cur.pm * tstepA; const char* cB = (const char*)g.Bt + (size_t)cur.pn * tstepB;
    PG8_STAGE(PG8_SB(0, 0), cB, voffB); PG8_STAGE(PG8_SB(0, 1), cB + hstepB, voffB); PG8_STAGE(PG8_SA(0, 0), cA, voffA); PG8_STAGE(PG8_SA(0, 1), cA + hstepA, voffA);
    if (wr == 1) PG8_BAR;
    PG8_WAIT_V(2); PG8_BAR;
    PG8_STAGE(PG8_SB(1, 0), cB + kstep, voffB); PG8_STAGE(PG8_SA(1, 0), cA + kstep, voffA); PG8_STAGE(PG8_SB(1, 1), cB + hstepB + kstep, voffB);
    PG8_WAIT_V(6); PG8_BAR;
    for (;;) {
        const bool has_next = S.next(ui + 1, nxt);
        const char* nA = has_next ? (const char*)g.A + (size_t)nxt.pm * tstepA : cA; const char* nB = has_next ? (const char*)g.Bt + (size_t)nxt.pn * tstepB : cB;
        for (int t = 0; t < nt; t += 2) {
            const bool last = (t == nt - 2);
            const char* a1 = cA + (size_t)(t + 1) * kstep;
            const char* a2 = last ? nA : cA + (size_t)(t + 2) * kstep; const char* b2 = last ? nB : cB + (size_t)(t + 2) * kstep;
            const char* a3 = a2 + kstep; const char* b3 = b2 + kstep;
            PG8_LDB(B0, 0, 0); PG8_LDB(B1, 0, 1); PG8_SCHED; PG8_LDA(At, 0, 0); PG8_STAGE(PG8_SA(1, 1), a1 + hstepA, voffA);
            PG8_WAIT_V(8); PG8_WAIT_L(0); PG8_BAR; PG8_MMA(0, 0, At, B0); PG8_MMA(0, 1, At, B1); PG8_BAR; PG8_SCHED;
            PG8_LDA(At, 0, 1); PG8_STAGE(PG8_SB(0, 0), b2, voffB); PG8_STAGE(PG8_SB(0, 1), b2 + hstepB, voffB); PG8_STAGE(PG8_SA(0, 0), a2, voffA);
            PG8_WAIT_V(8); PG8_WAIT_L(0); PG8_BAR; PG8_MMA(1, 0, At, B0); PG8_MMA(1, 1, At, B1); PG8_BAR; PG8_SCHED;
            PG8_LDB(B0, 1, 0); PG8_LDB(B1, 1, 1); PG8_SCHED; PG8_LDA(At, 1, 0); PG8_STAGE(PG8_SA(0, 1), a2 + hstepA, voffA);
            PG8_WAIT_V(8); PG8_WAIT_L(0); PG8_BAR; PG8_MMA(0, 0, At, B0); PG8_MMA(0, 1, At, B1); PG8_BAR; PG8_SCHED;
            PG8_LDA(At, 1, 1); PG8_STAGE(PG8_SB(1, 0), b3, voffB); PG8_STAGE(PG8_SB(1, 1), b3 + hstepB, voffB); PG8_STAGE(PG8_SA(1, 0), a3, voffA);
            PG8_WAIT_V(8); PG8_WAIT_L(0); PG8_BAR; PG8_MMA(1, 0, At, B0); PG8_MMA(1, 1, At, B1); PG8_BAR; PG8_SCHED;
        }
        if (wr == 0) PG8_BAR;
        E(acc, cur, wr, wc, fr, fq);
        if (!has_next) break;
#pragma unroll
        for (int a = 0; a < 2; ++a)
#pragma unroll
            for (int b = 0; b < 2; ++b)
#pragma unroll
                for (int m = 0; m < 4; ++m)
#pragma unroll
                    for (int n = 0; n < 2; ++n) acc[a][b][m][n] = (f32x4){0.f, 0.f, 0.f, 0.f};
        cur = nxt; cA = nA; cB = nB; ++ui;
        if (wr == 1) PG8_BAR;
    }
    PG8_WAIT_V(0);
    PG8_BAR;
#undef PG8_SA
#undef PG8_SB
#undef PG8_STAGE
#undef PG8_LDA
#undef PG8_LDB
#undef PG8_MMA
#undef PG8_WAIT_V
#undef PG8_WAIT_L
#undef PG8_BAR
#undef PG8_SCHED
}
}

struct EpiProj {
    static constexpr bool PERM = true;
    bf16_t* proj; const float* cs; const float* lbl;
    __device__ __forceinline__ void operator()(const f32x4 (&acc)[2][2][4][2], const pg8::Unit& u, int wr, int wc, int fr, int fq) const {
        asm volatile("s_nop 7\n\ts_nop 7\n\ts_nop 7" ::: "memory");
        const int type = u.pn >> 2;
        bf16_t* base = proj + (size_t)type * TSZ;
        const int row0 = u.pm * 256 + wr * 64 + fr;
        const int col0 = (u.pn & 3) * 256 + wc * 32 + 8 * fq;
        const bool rot = (type <= 1) && (wc == 0);
#pragma unroll
        for (int bj = 0; bj < 2; ++bj) {
            float lb[8];
            if (type == 4) {
                const f32x4 a0 = *(const f32x4*)(lbl + col0 + bj * 128), a1 = *(const f32x4*)(lbl + col0 + bj * 128 + 4);
                const f32x4 b0 = *(const f32x4*)(lbl + 1024 + col0 + bj * 128), b1 = *(const f32x4*)(lbl + 1024 + col0 + bj * 128 + 4);
#pragma unroll
                for (int e = 0; e < 4; ++e) { lb[e] = fast_sigmoid(a0[e] - b0[e]); lb[4 + e] = fast_sigmoid(a1[e] - b1[e]); }
            } else {
#pragma unroll
                for (int e = 0; e < 8; ++e) lb[e] = 0.f;
            }
#pragma unroll
            for (int ai = 0; ai < 2; ++ai)
#pragma unroll
                for (int m = 0; m < 4; ++m) {
                    const int row = row0 + ai * 128 + m * 16;
                    float v[8];
#pragma unroll
                    for (int e = 0; e < 4; ++e) { v[e] = acc[ai][bj][m][0][e]; v[4 + e] = acc[ai][bj][m][1][e]; }
                    if (rot) {
                        const float* cp = cs + (size_t)row * 32 + 8 * (fq & 1);
                        const f32x4 c0 = *(const f32x4*)(cp), c1 = *(const f32x4*)(cp + 4), s0 = *(const f32x4*)(cp + 16), s1 = *(const f32x4*)(cp + 20);
                        const float sg = (fq < 2) ? -1.f : 1.f;
#pragma unroll
                        for (int e = 0; e < 8; ++e) {
                            const float pv = __shfl_xor(v[e], 32);
                            const float cc = (e < 4) ? c0[e & 3] : c1[e & 3], ss = (e < 4) ? s0[e & 3] : s1[e & 3];
                            v[e] = v[e] * cc + sg * pv * ss;
                        }
                    } else if (type == 3) {
#pragma unroll
                        for (int e = 0; e < 8; ++e) v[e] = fast_silu(v[e]) * 0.08838834764831845f;
                    } else if (type == 4) {
#pragma unroll
                        for (int e = 0; e < 8; ++e) { const float f = lb[e] + (1.f - lb[e]) * fast_sigmoid(v[e]); v[e] = __logf(f); }
                    } else if (type == 6) {
#pragma unroll
                        for (int e = 0; e < 8; ++e) v[e] = fast_silu(v[e]);
                    }
                    u32x4 w; w.x = pk2_rne(v[0], v[1]); w.y = pk2_rne(v[2], v[3]); w.z = pk2_rne(v[4], v[5]); w.w = pk2_rne(v[6], v[7]);
                    __builtin_nontemporal_store(w, (u32x4*)(base + (size_t)row * 1024 + col0 + bj * 128));
                }
        }
    }
};
struct EpiDelta {
    static constexpr bool PERM = true;
    bf16_t* O; const float* g;
    __device__ __forceinline__ void operator()(const f32x4 (&acc)[2][2][4][2], const pg8::Unit& u, int wr, int wc, int fr, int fq) const {
        asm volatile("s_nop 7\n\ts_nop 7\n\ts_nop 7" ::: "memory");
        const int row0 = u.pm * 256 + wr * 64 + fr, col0 = u.pn * 256 + wc * 32 + 8 * fq;
        f32x4 gv[2][2];
#pragma unroll
        for (int bj = 0; bj < 2; ++bj)
#pragma unroll
            for (int n = 0; n < 2; ++n) gv[bj][n] = *(const f32x4*)(g + col0 + bj * 128 + 4 * n);
#pragma unroll
        for (int ai = 0; ai < 2; ++ai)
#pragma unroll
            for (int m = 0; m < 4; ++m) {
                bf16_t* rowp = O + (size_t)(row0 + ai * 128 + m * 16) * D + col0;
#pragma unroll
                for (int bj = 0; bj < 2; ++bj) {
                    const f32x4 v0 = acc[ai][bj][m][0] * gv[bj][0], v1 = acc[ai][bj][m][1] * gv[bj][1];
                    u32x4 w; w.x = pk2_rne(v0[0], v0[1]); w.y = pk2_rne(v0[2], v0[3]); w.z = pk2_rne(v1[0], v1[1]); w.w = pk2_rne(v1[2], v1[3]);
                    *(u32x4*)(rowp + bj * 128) = w;
                }
            }
    }
};
__device__ __forceinline__ float dpp_shr1(float old, float src) { return __int_as_float(__builtin_amdgcn_update_dpp(__float_as_int(old), __float_as_int(src), 0x111, 0xf, 0xf, false)); }
__device__ __forceinline__ float dpp_shr2(float old, float src) { return __int_as_float(__builtin_amdgcn_update_dpp(__float_as_int(old), __float_as_int(src), 0x112, 0xf, 0xf, false)); }
__device__ __forceinline__ float dpp_ror1(float src) { return __int_as_float(__builtin_amdgcn_mov_dpp(__float_as_int(src), 0x121, 0xf, 0xf, true)); }
__device__ __forceinline__ float dpp_ror2(float src) { return __int_as_float(__builtin_amdgcn_mov_dpp(__float_as_int(src), 0x122, 0xf, 0xf, true)); }
struct EpiUpConv {
    static constexpr bool PERM = true;
    bf16_t* ACT; float* head; float* halo; const float* cw; const float* cb; LAS float* xb;
    __device__ __forceinline__ void operator()(const f32x4 (&acc)[2][2][4][2], const pg8::Unit& u, int wr, int wc, int fr, int fq) const {
        asm volatile("s_nop 7\n\ts_nop 7\n\ts_nop 7" ::: "memory");
        const int cc0 = wc * 32 + 8 * fq;
        if (fr >= 14) {
#pragma unroll
            for (int ai = 0; ai < 2; ++ai)
#pragma unroll
                for (int bj = 0; bj < 2; ++bj)
#pragma unroll
                    for (int n = 0; n < 2; ++n) *(LAS f32x4*)(xb + ((2 * ai + wr) * 2 + (fr - 14)) * 256 + bj * 128 + cc0 + 4 * n) = acc[ai][bj][3][n];
            if (wr == 1) {
#pragma unroll
                for (int bj = 0; bj < 2; ++bj)
#pragma unroll
                    for (int n = 0; n < 2; ++n) *(f32x4*)(halo + ((size_t)u.pm * 2 + (fr - 14)) * UPW + u.pn * 256 + bj * 128 + cc0 + 4 * n) = acc[1][bj][3][n];
            }
        }
        if (wr == 0 && fr < 2) {
#pragma unroll
            for (int bj = 0; bj < 2; ++bj)
#pragma unroll
                for (int n = 0; n < 2; ++n) *(f32x4*)(head + ((size_t)u.pm * 2 + fr) * UPW + u.pn * 256 + bj * 128 + cc0 + 4 * n) = acc[0][bj][0][n];
        }
        asm volatile("s_waitcnt lgkmcnt(0)" ::: "memory"); __builtin_amdgcn_s_barrier(); asm volatile("" ::: "memory");
        const int row0 = u.pm * 256 + wr * 64 + fr;
        u32x2 lo[2][4];
#pragma unroll
        for (int n = 0; n < 2; ++n) {
            const int jg = u.pn * 128 + cc0 + 4 * n;
            const f32x4 g0w = *(const f32x4*)(cw + jg), g1w = *(const f32x4*)(cw + UPW + jg), g2w = *(const f32x4*)(cw + 2 * UPW + jg), gb = *(const f32x4*)(cb + jg);
            const f32x4 u0w = *(const f32x4*)(cw + DFF + jg), u1w = *(const f32x4*)(cw + UPW + DFF + jg), u2w = *(const f32x4*)(cw + 2 * UPW + DFF + jg), ub = *(const f32x4*)(cb + DFF + jg);
#pragma unroll
            for (int ai = 0; ai < 2; ++ai) {
                const int gi = 2 * ai + wr;
                f32x4 pg1 = (f32x4){0.f, 0.f, 0.f, 0.f}, pg2 = pg1, pu1 = pg1, pu2 = pg1;
                if (gi > 0) {
                    const LAS float* xp = xb + ((gi - 1) * 2) * 256 + cc0 + 4 * n;
                    pg1 = *(const LAS f32x4*)(xp + 256); pu1 = *(const LAS f32x4*)(xp + 256 + 128);
                    pg2 = *(const LAS f32x4*)(xp + (fr & 1) * 256); pu2 = *(const LAS f32x4*)(xp + (fr & 1) * 256 + 128);
                }
#pragma unroll
                for (int m = 0; m < 4; ++m) {
                    float a[4];
#pragma unroll
                    for (int e = 0; e < 4; ++e) {
                        const float gc = acc[ai][0][m][n][e], uc = acc[ai][1][m][n][e];
                        float og1, og2, ou1, ou2;
                        if (m == 0) { og1 = pg1[e]; og2 = pg2[e]; ou1 = pu1[e]; ou2 = pu2[e]; }
                        else { const float gp = acc[ai][0][m - 1][n][e], up = acc[ai][1][m - 1][n][e]; og1 = dpp_ror1(gp); og2 = dpp_ror2(gp); ou1 = dpp_ror1(up); ou2 = dpp_ror2(up); }
                        const float gm1 = dpp_shr1(og1, gc), gm2 = dpp_shr2(og2, gc), um1 = dpp_shr1(ou1, uc), um2 = dpp_shr2(ou2, uc);
                        const float yg = g0w[e] * gm2 + g1w[e] * gm1 + g2w[e] * gc + gb[e];
                        const float yu = u0w[e] * um2 + u1w[e] * um1 + u2w[e] * uc + ub[e];
                        a[e] = fast_silu(yg) * yu;
                    }
                    u32x2 pk; pk.x = cvt_pk_bf16(a[0], a[1]); pk.y = cvt_pk_bf16(a[2], a[3]);
                    if (n == 0) lo[ai][m] = pk;
                    else {
                        const bool skip = (gi == 0) && (m == 0) && (fr < 2);
                        if (!skip) __builtin_nontemporal_store((u32x4){lo[ai][m].x, lo[ai][m].y, pk.x, pk.y}, (u32x4*)(ACT + (size_t)(row0 + ai * 128 + m * 16) * DFF + u.pn * 128 + cc0));
                    }
                }
            }
        }
    }
};

struct Ctx {
    LAS unsigned char* lds; unsigned char* ws; float* out;
    const float *x, *c, *w_ada, *b_ada, *norm1_w, *w_in, *lb_logits, *gnorm_w, *w_out, *norm2_w, *w_up, *conv_w, *conv_b, *w_down, *final_w;
    const int* pos;
    int tid, lane, wave, G, gw, NGW;
};

__device__ __forceinline__ void transpose_item(const float* __restrict__ W, int K, int N, bf16_t* __restrict__ WT, LAS float* scr, int item, int lane, bool upmap = false) {
    const int nblk = N >> 6, kb = item / nblk, nb = item - kb * nblk, k0 = kb * 64, n0s = nb * 64;
    const int n0 = !upmap ? n0s : (n0s < DFF ? 256 * (n0s >> 7) + (n0s & 127) : 256 * ((n0s - DFF) >> 7) + 128 + ((n0s - DFF) & 127));
    const float* src = W + (size_t)k0 * N + n0s + lane;
#pragma unroll 16
    for (int i = 0; i < 64; ++i) scr[i * 65 + lane] = __builtin_nontemporal_load(src + (size_t)i * N);
    __builtin_amdgcn_wave_barrier();
    const int cch = lane & 7;
#pragma unroll
    for (int j = 0; j < 8; ++j) {
        const int n = (lane >> 3) + 8 * j; const LAS float* s = scr + (8 * cch) * 65 + n;
        u32x4 o; o.x = pk2_rne(s[0], s[65]); o.y = pk2_rne(s[2 * 65], s[3 * 65]); o.z = pk2_rne(s[4 * 65], s[5 * 65]); o.w = pk2_rne(s[6 * 65], s[7 * 65]);
        *(u32x4*)(WT + (size_t)(n0 + n) * K + k0 + 8 * cch) = o;
    }
    __builtin_amdgcn_wave_barrier();
}

__device__ __forceinline__ void phase_prologue(Ctx& X) {
    LAS float* scr = (LAS float*)(X.lds + X.wave * 16640);
    constexpr int I_IN = (D / 64) * (INW / 64), I_OUT = (D / 64) * (D / 64), I_UP = (D / 64) * (UPW / 64), I_DN = (DFF / 64) * (D / 64);
    constexpr int NIT = I_IN + I_OUT + I_UP + I_DN;
    bf16_t* win = (bf16_t*)(X.ws + WS_WIN); bf16_t* wout = (bf16_t*)(X.ws + WS_WOUT); bf16_t* wup = (bf16_t*)(X.ws + WS_WUP); bf16_t* wdn = (bf16_t*)(X.ws + WS_WDOWN);
    float* mod = (float*)(X.ws + WS_CTL);
    for (int task = X.gw; task < 48 * 32; task += X.NGW) {
        const int cb = task % 48, ks = task / 48;
        const f32x4* wp = (const f32x4*)(X.w_ada + (size_t)(ks * 64) * NMOD + cb * 256) + X.lane;
        f32x4 a = (f32x4){0.f, 0.f, 0.f, 0.f};
#pragma unroll 8
        for (int i = 0; i < 64; ++i) { const float cv = X.c[ks * 64 + i]; const float sv = cv / (1.f + __expf(-cv)); a += __builtin_nontemporal_load(wp + (size_t)i * (NMOD / 4)) * sv; }
        if (ks == 0) a += *((const f32x4*)(X.b_ada + cb * 256) + X.lane);
        float* mp = mod + cb * 256 + X.lane * 4;
        atomicAdd(mp + 0, a[0]); atomicAdd(mp + 1, a[1]); atomicAdd(mp + 2, a[2]); atomicAdd(mp + 3, a[3]);
    }
    for (int it = X.gw; it < NIT; it += X.NGW) {
        int r = it;
        if (r < I_IN) { transpose_item(X.w_in, D, INW, win, scr, r, X.lane); continue; } r -= I_IN;
        if (r < I_OUT) { transpose_item(X.w_out, D, D, wout, scr, r, X.lane); continue; } r -= I_OUT;
        if (r < I_UP) { transpose_item(X.w_up, D, UPW, wup, scr, r, X.lane, true); continue; } r -= I_UP;
        transpose_item(X.w_down, DFF, D, wdn, scr, r, X.lane);
    }
}

__device__ __forceinline__ void rows_norm_mod(Ctx& X, const float* src, const bf16_t* delta, float* x1out, const float* w, const float* sc, const float* sh, bf16_t* dst, bool do_cs) {
    f32x4 pa[8], pb[8];
#pragma unroll
    for (int j = 0; j < 8; ++j) { const int col = 4 * X.lane + 256 * j; pa[j] = *(const f32x4*)(w + col) * (*(const f32x4*)(sc + col) + 1.f); pb[j] = *(const f32x4*)(sh + col); }
    for (int row = X.gw; row < S; row += X.NGW) {
        const f32x4* xr = (const f32x4*)(src + (size_t)row * D) + X.lane;
        f32x4 v[8]; float ss = 0.f;
#pragma unroll
        for (int j = 0; j < 8; ++j) v[j] = __builtin_nontemporal_load(xr + 64 * j);
        if (delta) {
            const u32x2* dr = (const u32x2*)(delta + (size_t)row * D) + X.lane;
#pragma unroll
            for (int j = 0; j < 8; ++j) { const u32x2 d2 = dr[64 * j]; v[j][0] += bflo(d2.x); v[j][1] += bfhi(d2.x); v[j][2] += bflo(d2.y); v[j][3] += bfhi(d2.y); }
            if (x1out) {
                f32x4* xo = (f32x4*)(x1out + (size_t)row * D) + X.lane;
#pragma unroll
                for (int j = 0; j < 8; ++j) xo[64 * j] = v[j];
            }
        }
#pragma unroll
        for (int j = 0; j < 8; ++j) ss += (v[j][0] * v[j][0] + v[j][1] * v[j][1]) + (v[j][2] * v[j][2] + v[j][3] * v[j][3]);
        const float r = rsqrtf(wave_sum(ss) * (1.f / D) + EPS);
        u32x2* o8 = (u32x2*)(dst + (size_t)row * D) + X.lane;
#pragma unroll
        for (int j = 0; j < 8; ++j) {
            const f32x4 y = (v[j] * r) * pa[j] + pb[j];
            u32x2 p; p.x = pk2_rne(y[0], y[1]); p.y = pk2_rne(y[2], y[3]); o8[64 * j] = p;
        }
    }
    if (do_cs) {
        const int gt = blockIdx.x * 512 + X.tid, NT = X.G * 512;
        float* cs = (float*)(X.ws + WS_CS);
        for (int idx = gt; idx < S * 16; idx += NT) {
            const int rw = idx >> 4, i = idx & 15;
            const float invf = 1.0f / powf(500000.0f, (float)(2 * i) * (1.0f / 32.0f));
            const float ang = (float)X.pos[rw] * invf;
            cs[(size_t)rw * 32 + i] = cosf(ang); cs[(size_t)rw * 32 + 16 + i] = sinf(ang);
        }
    }
}

__device__ __forceinline__ void rows_final(Ctx& X) {
    const bf16_t* d1 = (const bf16_t*)(X.ws + WS_D1); const bf16_t* d2 = (const bf16_t*)(X.ws + WS_D2);
    f32x4 fw[8];
#pragma unroll
    for (int j = 0; j < 8; ++j) fw[j] = *(const f32x4*)(X.final_w + 4 * X.lane + 256 * j);
    for (int row = X.gw; row < S; row += X.NGW) {
        const f32x4* xr = (const f32x4*)(X.x + (size_t)row * D) + X.lane;
        f32x4* orow = (f32x4*)(X.out + (size_t)row * D) + X.lane;
        const u32x2* ar = (const u32x2*)(d1 + (size_t)row * D) + X.lane; const u32x2* br = (const u32x2*)(d2 + (size_t)row * D) + X.lane;
        f32x4 v[8]; float ss = 0.f;
#pragma unroll
        for (int j = 0; j < 8; ++j) { v[j] = __builtin_nontemporal_load(xr + 64 * j); const u32x2 a2 = __builtin_nontemporal_load(ar + 64 * j), b2 = __builtin_nontemporal_load(br + 64 * j);
            v[j][0] += bflo(a2.x) + bflo(b2.x); v[j][1] += bfhi(a2.x) + bfhi(b2.x); v[j][2] += bflo(a2.y) + bflo(b2.y); v[j][3] += bfhi(a2.y) + bfhi(b2.y); }
#pragma unroll
        for (int j = 0; j < 8; ++j) ss += (v[j][0] * v[j][0] + v[j][1] * v[j][1]) + (v[j][2] * v[j][2] + v[j][3] * v[j][3]);
        const float r = rsqrtf(wave_sum(ss) * (1.f / D) + EPS);
#pragma unroll
        for (int j = 0; j < 8; ++j) __builtin_nontemporal_store((v[j] * r) * fw[j], orow + 64 * j);
    }
}

typedef short s16x4 __attribute__((ext_vector_type(4)));
template <int S2>
__device__ __forceinline__ void tr_load8(unsigned addr, s16x4 (&t)[8]) {
    asm volatile("ds_read_b64_tr_b16 %0, %8 offset:%9\n\t"
                 "ds_read_b64_tr_b16 %1, %8 offset:%10\n\t"
                 "ds_read_b64_tr_b16 %2, %8 offset:%11\n\t"
                 "ds_read_b64_tr_b16 %3, %8 offset:%12\n\t"
                 "ds_read_b64_tr_b16 %4, %8 offset:%13\n\t"
                 "ds_read_b64_tr_b16 %5, %8 offset:%14\n\t"
                 "ds_read_b64_tr_b16 %6, %8 offset:%15\n\t"
                 "ds_read_b64_tr_b16 %7, %8 offset:%16\n\t"
                 "s_waitcnt lgkmcnt(0)"
                 : "=&v"(t[0]), "=&v"(t[1]), "=&v"(t[2]), "=&v"(t[3]), "=&v"(t[4]), "=&v"(t[5]), "=&v"(t[6]), "=&v"(t[7])
                 : "v"(addr), "i"(16 * S2 * 272 + 0), "i"(16 * S2 * 272 + 8 * 272 + 0), "i"(16 * S2 * 272 + 64), "i"(16 * S2 * 272 + 8 * 272 + 64),
                   "i"(16 * S2 * 272 + 128), "i"(16 * S2 * 272 + 8 * 272 + 128), "i"(16 * S2 * 272 + 192), "i"(16 * S2 * 272 + 8 * 272 + 192)
                 : "memory");
}
template <int S2>
__device__ __forceinline__ void tr_issue8(unsigned addr, s16x4 (&t)[8]) {
    asm volatile("ds_read_b64_tr_b16 %0, %8 offset:%9\n\t"
                 "ds_read_b64_tr_b16 %1, %8 offset:%10\n\t"
                 "ds_read_b64_tr_b16 %2, %8 offset:%11\n\t"
                 "ds_read_b64_tr_b16 %3, %8 offset:%12\n\t"
                 "ds_read_b64_tr_b16 %4, %8 offset:%13\n\t"
                 "ds_read_b64_tr_b16 %5, %8 offset:%14\n\t"
                 "ds_read_b64_tr_b16 %6, %8 offset:%15\n\t"
                 "ds_read_b64_tr_b16 %7, %8 offset:%16"
                 : "=&v"(t[0]), "=&v"(t[1]), "=&v"(t[2]), "=&v"(t[3]), "=&v"(t[4]), "=&v"(t[5]), "=&v"(t[6]), "=&v"(t[7])
                 : "v"(addr), "i"(16 * S2 * 272 + 0), "i"(16 * S2 * 272 + 8 * 272 + 0), "i"(16 * S2 * 272 + 64), "i"(16 * S2 * 272 + 8 * 272 + 64),
                   "i"(16 * S2 * 272 + 128), "i"(16 * S2 * 272 + 8 * 272 + 128), "i"(16 * S2 * 272 + 192), "i"(16 * S2 * 272 + 8 * 272 + 192)
                 : "memory");
}
__device__ __forceinline__ void tr_wait8(s16x4 (&t)[8]) {
    asm volatile("s_waitcnt lgkmcnt(0)" : "+v"(t[0]), "+v"(t[1]), "+v"(t[2]), "+v"(t[3]), "+v"(t[4]), "+v"(t[5]), "+v"(t[6]), "+v"(t[7]) : : "memory");
}
__device__ __forceinline__ void attn_item(int id, const bf16_t* __restrict__ AQ, const bf16_t* __restrict__ AK, const bf16_t* __restrict__ AV, bf16_t* __restrict__ OP, float* __restrict__ LSE,
                                          LAS bf16_t* kl, LAS bf16_t* vl, int lane) {
    const int p = id >> 12, rem = id & 4095, hd = rem >> 9, tl = rem & 511;
    const int lg = (p == 0) ? 0 : (p == 1) ? 2 : 4, dl = 1 << lg;
    const int res = tl >> (9 - lg), tt = tl & ((512 >> lg) - 1), tau0 = tt * 32;
    const int r = lane & 31, h = lane >> 5;
    const size_t qtok = (size_t)(res + dl * (tau0 + r));
    const int kt0 = (tau0 >= 128) ? 0 : ((128 - tau0) >> 5);
    const int lkey = lane >> 4, lch = lane & 15, rr = r - 4 * h;
    u32x4 kr[8], vr[8];
    const unsigned istep = (unsigned)(4 * dl) * 2048u, tstep = (unsigned)(32 * dl) * 2048u;
    unsigned voff = (unsigned)((res + dl * (tau0 - 128 + 32 * kt0 + lkey)) * 1024 + hd * 128 + 8 * lch) * 2u;
    {
#pragma unroll
        for (int it = 0; it < 8; ++it) { kr[it] = *(const u32x4*)((const char*)AK + (voff + it * istep)); vr[it] = *(const u32x4*)((const char*)AV + (voff + it * istep)); }
    }
    bf16x8 qf[8];
#pragma unroll
    for (int j = 0; j < 8; ++j) qf[j] = *(const bf16x8*)(AQ + qtok * 1024 + hd * 128 + 16 * j + 8 * h);
    f32x16 o[4];
#pragma unroll
    for (int dt = 0; dt < 4; ++dt)
#pragma unroll
        for (int i = 0; i < 16; ++i) o[dt][i] = 0.f;
    float mrun = -INFINITY, lrun = 0.f;
    const float scl = 0.08838834764831845f * 1.4426950408889634f;
    const unsigned vaddr = (unsigned)(size_t)vl + (unsigned)(((4 * (lane >> 5) + ((lane & 15) >> 2)) * 136 + 16 * ((lane >> 4) & 1) + 4 * (lane & 3)) * 2);
    for (int kt = kt0; kt < 5; ++kt) {
#pragma unroll
        for (int it = 0; it < 8; ++it) { *(LAS u32x4*)(kl + (4 * it + lkey) * 136 + 8 * lch) = kr[it]; *(LAS u32x4*)(vl + (4 * it + lkey) * 136 + 8 * lch) = vr[it]; }
        if (kt < 4) {
            voff += tstep;
#pragma unroll
            for (int it = 0; it < 8; ++it) { kr[it] = *(const u32x4*)((const char*)AK + (voff + it * istep)); vr[it] = *(const u32x4*)((const char*)AV + (voff + it * istep)); }
        }
        __builtin_amdgcn_wave_barrier();
        f32x16 s;
#pragma unroll
        for (int i = 0; i < 16; ++i) s[i] = 0.f;
        {
            bf16x8 kf[8];
#pragma unroll
            for (int j = 0; j < 8; ++j) kf[j] = *(const LAS bf16x8*)(kl + r * 136 + 16 * j + 8 * h);
            __builtin_amdgcn_sched_barrier(0);
#pragma unroll
            for (int j = 0; j < 8; ++j) s = MFMA32(kf[j], qf[j], s);
        }
        s16x4 tq0[8];
        tr_issue8<0>(vaddr, tq0);
        if (kt == 0) {
#pragma unroll
            for (int i = 0; i < 16; ++i) s[i] = (((i & 3) + 8 * (i >> 2)) >= rr) ? s[i] : -INFINITY;
        } else if (kt == 4) {
#pragma unroll
            for (int i = 0; i < 16; ++i) s[i] = (((i & 3) + 8 * (i >> 2)) <= rr) ? s[i] : -INFINITY;
        }
        float mx = fmaxf(fmaxf(s[0], s[1]), fmaxf(s[2], s[3]));
#pragma unroll
        for (int i = 4; i < 16; i += 4) mx = fmaxf(mx, fmaxf(fmaxf(s[i], s[i + 1]), fmaxf(s[i + 2], s[i + 3])));
        mx = fmaxf(mx, __shfl_xor(mx, 32));
        const float mnew = fmaxf(mrun, mx * scl);
        const float alpha = __builtin_amdgcn_exp2f(mrun - mnew);
        float rs = 0.f;
#pragma unroll
        for (int i = 0; i < 16; ++i) { s[i] = __builtin_amdgcn_exp2f(__builtin_fmaf(s[i], scl, -mnew)); rs += s[i]; }
        rs += __shfl_xor(rs, 32);
        lrun = lrun * alpha + rs; mrun = mnew;
        if (__builtin_amdgcn_readfirstlane(__any(alpha != 1.0f) ? 1 : 0)) {
#pragma unroll
            for (int dt = 0; dt < 4; ++dt)
#pragma unroll
                for (int i = 0; i < 16; ++i) o[dt][i] *= alpha;
        }
        bf16x8 pf[2];
#pragma unroll
        for (int s2 = 0; s2 < 2; ++s2) {
            u32x4 w; w.x = pk2_rne(s[8 * s2 + 0], s[8 * s2 + 1]); w.y = pk2_rne(s[8 * s2 + 2], s[8 * s2 + 3]); w.z = pk2_rne(s[8 * s2 + 4], s[8 * s2 + 5]); w.w = pk2_rne(s[8 * s2 + 6], s[8 * s2 + 7]);
            pf[s2] = __builtin_bit_cast(bf16x8, w);
        }
        {
            s16x4 tq1[8];
            tr_wait8(tq0);
            tr_issue8<1>(vaddr, tq1);
#pragma unroll
            for (int dt = 0; dt < 4; ++dt) { const bf16x8 af = __builtin_shufflevector(tq0[2 * dt], tq0[2 * dt + 1], 0, 1, 2, 3, 4, 5, 6, 7); o[dt] = MFMA32(af, pf[0], o[dt]); }
            tr_wait8(tq1);
#pragma unroll
            for (int dt = 0; dt < 4; ++dt) { const bf16x8 af = __builtin_shufflevector(tq1[2 * dt], tq1[2 * dt + 1], 0, 1, 2, 3, 4, 5, 6, 7); o[dt] = MFMA32(af, pf[1], o[dt]); }
        }
        __builtin_amdgcn_wave_barrier();
    }
    const float inv = 1.0f / lrun;
    bf16_t* op = OP + (size_t)p * TSZ + qtok * 1024 + hd * 128 + 4 * h;
#pragma unroll
    for (int dt = 0; dt < 4; ++dt)
#pragma unroll
        for (int g = 0; g < 4; ++g) {
            u32x2 w; w.x = pk2_rne(o[dt][4 * g] * inv, o[dt][4 * g + 1] * inv); w.y = pk2_rne(o[dt][4 * g + 2] * inv, o[dt][4 * g + 3] * inv);
            *(u32x2*)(op + 32 * dt + 8 * g) = w;
        }
    if (h == 0) LSE[((size_t)p * 8 + hd) * S + qtok] = mrun + __log2f(lrun);
}

#define ATT_TILE_VALID(T) (((T) >= 0) && ((T) < nq + 4) && (32 * (x0 + (T)) - 128 >= 0))
#define ATT_XL(T) (((T) < w) ? w : (w + 8 * ((((T) - w) >> 3) < (nq >> 3) - 1 ? (((T) - w) >> 3) : (nq >> 3) - 1)))
#define ATT_VOFF(T) ((unsigned)((res + dl * (32 * (x0 + (T)) - 128 + myrow)) * 1024 + hd * 128 + 8 * lch) * 2u)
#define ATT_BOOK(T) do { const int t1_ = (T) + 1, xl1_ = ATT_XL(t1_), kt1_ = t1_ - xl1_; \
        if (kt1_ >= 0 && kt1_ <= 4 && ATT_TILE_VALID(t1_) && (kt1_ == 0 || !ATT_TILE_VALID(t1_ - 1))) { \
            qtok = (size_t)(res + dl * (32 * (x0 + xl1_) + r)); \
            _Pragma("unroll") for (int j = 0; j < 8; ++j) qf[j] = *(const bf16x8*)(AQ + qtok * 1024 + hd * 128 + 16 * j + 8 * h); \
            _Pragma("unroll") for (int dt = 0; dt < 4; ++dt) _Pragma("unroll") for (int i = 0; i < 16; ++i) o[dt][i] = 0.f; \
            mrun = -INFINITY; lrun = 0.f; } } while (0)
#define ATT_STEP(T, KS, VS, KW, VW, KR, VADDR) do { \
        if (ATT_TILE_VALID((T) + 1)) { *(LAS u32x4*)((KW) + myrow * 136 + 8 * lch) = KS; *(LAS u32x4*)((VW) + myrow * 136 + 8 * lch) = VS; } \
        if (ATT_TILE_VALID((T) + 3)) { const unsigned vo_ = ATT_VOFF((T) + 3); KS = *(const u32x4*)((const char*)AK + vo_); VS = *(const u32x4*)((const char*)AV + vo_); } \
        ATT_BOOK(T); \
        { const int xl_ = ATT_XL(T), kt_ = (T) - xl_; \
          if (kt_ >= 0 && kt_ <= 4 && ATT_TILE_VALID(T)) attn_tile(KR, VADDR, kt_, qf, o, mrun, lrun, r, h, rr, p, hd, qtok, OP, LSE); } \
        asm volatile("s_waitcnt lgkmcnt(0)" ::: "memory"); __builtin_amdgcn_s_barrier(); asm volatile("" ::: "memory"); } while (0)

__device__ __forceinline__ void attn_tile(const LAS bf16_t* kl, unsigned vaddr, int kt, const bf16x8 (&qf)[8], f32x16 (&o)[4], float& mrun, float& lrun, int r, int h, int rr, int p, int hd, size_t qtok,
                                          bf16_t* __restrict__ OP, float* __restrict__ LSE) {
    const float scl = 0.08838834764831845f * 1.4426950408889634f;
    f32x16 s, sb;
#pragma unroll
    for (int i = 0; i < 16; ++i) { s[i] = 0.f; sb[i] = 0.f; }
    {
        bf16x8 kf[8];
#pragma unroll
        for (int j = 0; j < 8; ++j) kf[j] = *(const LAS bf16x8*)(kl + r * 136 + 16 * j + 8 * h);
        __builtin_amdgcn_sched_barrier(0);
#pragma unroll
        for (int j = 0; j < 8; j += 2) { s = MFMA32(kf[j], qf[j], s); sb = MFMA32(kf[j + 1], qf[j + 1], sb); }
    }
#pragma unroll
    for (int i = 0; i < 16; ++i) s[i] += sb[i];
    s16x4 tq0[8];
    tr_issue8<0>(vaddr, tq0);
    if (kt == 0) {
#pragma unroll
        for (int i = 0; i < 16; ++i) s[i] = (((i & 3) + 8 * (i >> 2)) >= rr) ? s[i] : -INFINITY;
    } else if (kt == 4) {
#pragma unroll
        for (int i = 0; i < 16; ++i) s[i] = (((i & 3) + 8 * (i >> 2)) <= rr) ? s[i] : -INFINITY;
    }
    float mx = fmaxf(fmaxf(s[0], s[1]), fmaxf(s[2], s[3]));
#pragma unroll
    for (int i = 4; i < 16; i += 4) mx = fmaxf(mx, fmaxf(fmaxf(s[i], s[i + 1]), fmaxf(s[i + 2], s[i + 3])));
    { const auto pr = __builtin_amdgcn_permlane32_swap(__float_as_uint(mx), __float_as_uint(mx), false, false); mx = fmaxf(__uint_as_float(pr[0]), __uint_as_float(pr[1])); }
    const float mnew = fmaxf(mrun, mx * scl);
    const float alpha = __builtin_amdgcn_exp2f(mrun - mnew);
    float rs = 0.f;
#pragma unroll
    for (int i = 0; i < 16; ++i) { s[i] = __builtin_amdgcn_exp2f(__builtin_fmaf(s[i], scl, -mnew)); rs += s[i]; }
    { const auto pr = __builtin_amdgcn_permlane32_swap(__float_as_uint(rs), __float_as_uint(rs), false, false); rs = __uint_as_float(pr[0]) + __uint_as_float(pr[1]); }
    lrun = lrun * alpha + rs; mrun = mnew;
    if (__builtin_amdgcn_readfirstlane(__any(alpha != 1.0f) ? 1 : 0)) {
#pragma unroll
        for (int dt = 0; dt < 4; ++dt)
#pragma unroll
            for (int i = 0; i < 16; ++i) o[dt][i] *= alpha;
    }
    bf16x8 pf[2];
#pragma unroll
    for (int s2 = 0; s2 < 2; ++s2) {
        u32x4 wv; wv.x = pk2_rne(s[8 * s2 + 0], s[8 * s2 + 1]); wv.y = pk2_rne(s[8 * s2 + 2], s[8 * s2 + 3]); wv.z = pk2_rne(s[8 * s2 + 4], s[8 * s2 + 5]); wv.w = pk2_rne(s[8 * s2 + 6], s[8 * s2 + 7]);
        pf[s2] = __builtin_bit_cast(bf16x8, wv);
    }
    {
        s16x4 tq1[8];
        tr_wait8(tq0);
        tr_issue8<1>(vaddr, tq1);
#pragma unroll
        for (int dt = 0; dt < 4; ++dt) { const bf16x8 af = __builtin_shufflevector(tq0[2 * dt], tq0[2 * dt + 1], 0, 1, 2, 3, 4, 5, 6, 7); o[dt] = MFMA32(af, pf[0], o[dt]); }
        tr_wait8(tq1);
#pragma unroll
        for (int dt = 0; dt < 4; ++dt) { const bf16x8 af = __builtin_shufflevector(tq1[2 * dt], tq1[2 * dt + 1], 0, 1, 2, 3, 4, 5, 6, 7); o[dt] = MFMA32(af, pf[1], o[dt]); }
    }
    if (kt == 4) {
        const float inv = 1.0f / lrun;
        bf16_t* op = OP + (size_t)p * TSZ + qtok * 1024 + hd * 128 + 4 * h;
#pragma unroll
        for (int dt = 0; dt < 4; ++dt)
#pragma unroll
            for (int g = 0; g < 4; ++g) {
                u32x2 wv; wv.x = pk2_rne(o[dt][4 * g] * inv, o[dt][4 * g + 1] * inv); wv.y = pk2_rne(o[dt][4 * g + 2] * inv, o[dt][4 * g + 3] * inv);
                *(u32x2*)(op + 32 * dt + 8 * g) = wv;
            }
        if (h == 0) LSE[((size_t)p * 8 + hd) * S + qtok] = mrun + __log2f(lrun);
    }
}

__device__ __forceinline__ void attn_run_coop(int nq, int p, int hd, int res, int x0, const bf16_t* __restrict__ AQ, const bf16_t* __restrict__ AK, const bf16_t* __restrict__ AV, bf16_t* __restrict__ OP, float* __restrict__ LSE,
                                              LAS bf16_t* lbase, int lane, int w) {
    const int lg = (p == 0) ? 0 : (p == 1) ? 2 : 4, dl = 1 << lg;
    const int r = lane & 31, h = lane >> 5, lkey = lane >> 4, lch = lane & 15, rr = r - 4 * h, myrow = 4 * w + lkey;
    LAS bf16_t* const K0 = lbase; LAS bf16_t* const V0 = lbase + 4352; LAS bf16_t* const K1 = lbase + 8704; LAS bf16_t* const V1 = lbase + 8704 + 4352;
    const unsigned lanepart = (unsigned)(((4 * (lane >> 5) + ((lane & 15) >> 2)) * 136 + 16 * ((lane >> 4) & 1) + 4 * (lane & 3)) * 2);
    const unsigned vaddr0 = (unsigned)(size_t)V0 + lanepart, vaddr1 = (unsigned)(size_t)V1 + lanepart;
    u32x4 kA = (u32x4){0u, 0u, 0u, 0u}, vA = kA, kB = kA, vB = kA;
    bf16x8 qf[8]; f32x16 o[4]; float mrun = -INFINITY, lrun = 0.f; size_t qtok = 0;
#pragma unroll
    for (int j = 0; j < 8; ++j) qf[j] = (bf16x8){0, 0, 0, 0, 0, 0, 0, 0};
#pragma unroll
    for (int dt = 0; dt < 4; ++dt)
#pragma unroll
        for (int i = 0; i < 16; ++i) o[dt][i] = 0.f;
    if (ATT_TILE_VALID(0)) { const unsigned vo = ATT_VOFF(0); kA = *(const u32x4*)((const char*)AK + vo); vA = *(const u32x4*)((const char*)AV + vo); }
    if (ATT_TILE_VALID(1)) { const unsigned vo = ATT_VOFF(1); kB = *(const u32x4*)((const char*)AK + vo); vB = *(const u32x4*)((const char*)AV + vo); }
    ATT_BOOK(-1);
    if (ATT_TILE_VALID(0)) { *(LAS u32x4*)(K0 + myrow * 136 + 8 * lch) = kA; *(LAS u32x4*)(V0 + myrow * 136 + 8 * lch) = vA; }
    if (ATT_TILE_VALID(2)) { const unsigned vo = ATT_VOFF(2); kA = *(const u32x4*)((const char*)AK + vo); vA = *(const u32x4*)((const char*)AV + vo); }
    asm volatile("s_waitcnt lgkmcnt(0)" ::: "memory"); __builtin_amdgcn_s_barrier(); asm volatile("" ::: "memory");
    for (int t = 0; t < nq + 4; t += 2) {
        ATT_STEP(t, kB, vB, K1, V1, K0, vaddr0);
        ATT_STEP(t + 1, kA, vA, K0, V0, K1, vaddr1);
    }
}

struct RawA { unsigned short lf[16], vv[16]; };
__device__ __forceinline__ void hgrn_a_load(Ctx& X, int u, RawA& R) {
    const int hd = u & 7, c = u >> 3, t0 = c * 64, seg = X.tid >> 7, k = X.tid & 127;
    const bf16_t* HLF = (const bf16_t*)(X.ws + WS_PROJ) + 4 * TSZ; const bf16_t* HV = (const bf16_t*)(X.ws + WS_PROJ) + 5 * TSZ;
#pragma unroll
    for (int i = 0; i < 16; ++i) { const size_t off = (size_t)(t0 + 16 * seg + i) * 1024 + hd * 128 + k; R.lf[i] = HLF[off]; R.vv[i] = HV[off]; }
}
__device__ __forceinline__ void hgrn_a_compute(Ctx& X, int u, const RawA& R) {
    const int tid = X.tid, seg = tid >> 7, k = tid & 127, lane = X.lane, w = X.wave, r = lane & 31, h = lane >> 5;
    LAS bf16_t* KT = (LAS bf16_t*)(X.lds);
    LAS bf16_t* VT = (LAS bf16_t*)(X.lds + 18432);
    LAS float* SEG = (LAS float*)(X.lds + 36864);
    float lf[16], b[16]; float run = 0.f;
#pragma unroll
    for (int i = 0; i < 16; ++i) { lf[i] = bf2f(R.lf[i]); run += lf[i]; b[i] = run; }
    SEG[seg * 128 + k] = run;
    __syncthreads();
    float off = 0.f, tot = 0.f;
#pragma unroll
    for (int s = 0; s < 4; ++s) { const float v = SEG[s * 128 + k]; tot += v; off += (s < seg) ? v : 0.f; }
    {
        unsigned pk[8], pv[8];
#pragma unroll
        for (int i = 0; i < 8; ++i) {
            const float k0 = (1.f - __expf(lf[2 * i])) * __expf(tot - (off + b[2 * i])), k1 = (1.f - __expf(lf[2 * i + 1])) * __expf(tot - (off + b[2 * i + 1]));
            pk[i] = pk2_rne(k0, k1); pv[i] = (unsigned)R.vv[2 * i] | ((unsigned)R.vv[2 * i + 1] << 16);
        }
        *(LAS u32x4*)(KT + k * 72 + 16 * seg) = (u32x4){pk[0], pk[1], pk[2], pk[3]}; *(LAS u32x4*)(KT + k * 72 + 16 * seg + 8) = (u32x4){pk[4], pk[5], pk[6], pk[7]};
        *(LAS u32x4*)(VT + k * 72 + 16 * seg) = (u32x4){pv[0], pv[1], pv[2], pv[3]}; *(LAS u32x4*)(VT + k * 72 + 16 * seg + 8) = (u32x4){pv[4], pv[5], pv[6], pv[7]};
    }
    if (seg == 0) ((float*)(X.ws + WS_DBUF))[(size_t)u * 128 + k] = __expf(tot);
    __syncthreads();
    const int vt = w >> 1, kt2 = 2 * (w & 1);
    f32x16 acc[2];
#pragma unroll
    for (int e = 0; e < 2; ++e)
#pragma unroll
        for (int i = 0; i < 16; ++i) acc[e][i] = 0.f;
#pragma unroll
    for (int ks = 0; ks < 4; ++ks) {
        const bf16x8 bfr = *(const LAS bf16x8*)(VT + (32 * vt + r) * 72 + 16 * ks + 8 * h);
#pragma unroll
        for (int e = 0; e < 2; ++e) { const bf16x8 af = *(const LAS bf16x8*)(KT + (32 * (kt2 + e) + r) * 72 + 16 * ks + 8 * h); acc[e] = MFMA32(af, bfr, acc[e]); }
    }
    bf16_t* P = (bf16_t*)X.out + (size_t)u * 16384;
#pragma unroll
    for (int e = 0; e < 2; ++e)
#pragma unroll
        for (int g = 0; g < 4; ++g) {
            { u32x2 pw; pw.x = pk2_rne(acc[e][4 * g], acc[e][4 * g + 1]); pw.y = pk2_rne(acc[e][4 * g + 2], acc[e][4 * g + 3]);
              *(u32x2*)(P + (32 * vt + r) * 128 + 32 * (kt2 + e) + 8 * g + 4 * h) = pw; }
        }
    __syncthreads();
}

struct RawC { unsigned short lf[16], q[16], vv[16]; };
__device__ __forceinline__ void hgrn_c_load(Ctx& X, int u, RawC& R) {
    const int hd = u & 7, c = u >> 3, t0 = c * 64, seg = X.tid >> 7, k = X.tid & 127;
    const bf16_t* PR = (const bf16_t*)(X.ws + WS_PROJ);
    const bf16_t* HQ = PR + 3 * TSZ; const bf16_t* HLF = PR + 4 * TSZ; const bf16_t* HV = PR + 5 * TSZ;
#pragma unroll
    for (int i = 0; i < 16; ++i) { const size_t off = (size_t)(t0 + 16 * seg + i) * 1024 + hd * 128 + k; R.lf[i] = HLF[off]; R.q[i] = HQ[off]; R.vv[i] = HV[off]; }
}
__device__ __forceinline__ void hgrn_c_compute(Ctx& X, int u, const RawC& R) {
    const int hd = u & 7, c = u >> 3, t0 = c * 64;
    const int tid = X.tid, seg = tid >> 7, k = tid & 127, lane = X.lane, w = X.wave, r = lane & 31, h = lane >> 5;
    LAS bf16_t* QH = (LAS bf16_t*)(X.lds);
    LAS bf16_t* QT = (LAS bf16_t*)(X.lds + 17408);
    LAS bf16_t* KT2 = (LAS bf16_t*)(X.lds + 34816);
    LAS bf16_t* VT = (LAS bf16_t*)(X.lds + 52224);
    LAS bf16_t* AM = (LAS bf16_t*)(X.lds + 70656);
    LAS float* OF = (LAS float*)(X.lds + 79872);
    LAS float* SEG = (LAS float*)(X.lds + 113664);
    const bf16_t* HG = (const bf16_t*)(X.ws + WS_PROJ) + 6 * TSZ;
    const int tt2 = w & 1, vt2 = w >> 1;
    bf16x8 sfr[8];
    {
        const bf16_t* sb = (const bf16_t*)(X.ws + WS_SBUF) + (size_t)u * 16384 + (32 * vt2 + r) * 128 + 8 * h;
#pragma unroll
        for (int kk = 0; kk < 8; ++kk) sfr[kk] = *(const bf16x8*)(sb + 16 * kk);
    }
    const int tn = tid >> 3, sub = tid & 7;
    const u32x4 g0 = *(const u32x4*)(HG + (size_t)(t0 + tn) * 1024 + hd * 128 + 16 * sub), g1 = *(const u32x4*)(HG + (size_t)(t0 + tn) * 1024 + hd * 128 + 16 * sub + 8);
    {
        float lf[16], b[16]; float run = 0.f;
#pragma unroll
        for (int i = 0; i < 16; ++i) { lf[i] = bf2f(R.lf[i]); run += lf[i]; b[i] = run; }
        SEG[seg * 128 + k] = run;
        __syncthreads();
        float off = 0.f;
#pragma unroll
        for (int s = 0; s < 4; ++s) { const float v = SEG[s * 128 + k]; off += (s < seg) ? v : 0.f; }
        const float bmid = SEG[k] + SEG[128 + k];
        unsigned pv[8];
#pragma unroll
        for (int i = 0; i < 16; ++i) {
            const float bt = off + b[i]; const int t = 16 * seg + i; const float q = bf2f(R.q[i]);
            const unsigned qh = pk2_rne(q * __expf(bt), q * __expf(bt - bmid));
            const unsigned kk = pk2_rne((1.f - __expf(lf[i])) * __expf(bmid - bt), 0.f);
            QH[t * 136 + k] = (bf16_t)(qh & 0xffffu); QT[t * 136 + k] = (bf16_t)(qh >> 16); KT2[t * 136 + k] = (bf16_t)(kk & 0xffffu);
        }
#pragma unroll
        for (int i = 0; i < 8; ++i) pv[i] = (unsigned)R.vv[2 * i] | ((unsigned)R.vv[2 * i + 1] << 16);
        *(LAS u32x4*)(VT + k * 72 + 16 * seg) = (u32x4){pv[0], pv[1], pv[2], pv[3]}; *(LAS u32x4*)(VT + k * 72 + 16 * seg + 8) = (u32x4){pv[4], pv[5], pv[6], pv[7]};
    }
    __syncthreads();
    if (w < 4) {
        const int st = w >> 1, tt = w & 1;
        f32x16 acc;
#pragma unroll
        for (int i = 0; i < 16; ++i) acc[i] = 0.f;
        if (!(st == 1 && tt == 0)) {
#pragma unroll
            for (int kk = 0; kk < 8; ++kk) {
                const bf16x8 af = *(const LAS bf16x8*)(KT2 + (32 * st + r) * 136 + 16 * kk + 8 * h);
                const bf16x8 bfr = *(const LAS bf16x8*)(QT + (32 * tt + r) * 136 + 16 * kk + 8 * h);
                acc = MFMA32(af, bfr, acc);
            }
        }
        const int t = 32 * tt + r;
#pragma unroll
        for (int g = 0; g < 4; ++g) {
            float v[4];
#pragma unroll
            for (int e = 0; e < 4; ++e) { const int s = 32 * st + 8 * g + 4 * h + e; v[e] = (s <= t) ? acc[4 * g + e] : 0.f; }
            u32x2 pw; pw.x = pk2_rne(v[0], v[1]); pw.y = pk2_rne(v[2], v[3]);
            *(LAS u32x2*)(AM + t * 72 + 32 * st + 8 * g + 4 * h) = pw;
        }
    }
    __syncthreads();
    {
        f32x16 acc;
#pragma unroll
        for (int i = 0; i < 16; ++i) acc[i] = 0.f;
#pragma unroll
        for (int kk = 0; kk < 8; ++kk) {
            const bf16x8 af = *(const LAS bf16x8*)(QH + (32 * tt2 + r) * 136 + 16 * kk + 8 * h);
            acc = MFMA32(af, sfr[kk], acc);
        }
#pragma unroll
        for (int ks = 0; ks < 4; ++ks) {
            const bf16x8 af = *(const LAS bf16x8*)(AM + (32 * tt2 + r) * 72 + 16 * ks + 8 * h);
            const bf16x8 bfr = *(const LAS bf16x8*)(VT + (32 * vt2 + r) * 72 + 16 * ks + 8 * h);
            acc = MFMA32(af, bfr, acc);
        }
#pragma unroll
        for (int i = 0; i < 16; ++i) OF[(32 * tt2 + crow(i, h)) * 132 + 32 * vt2 + r] = acc[i];
    }
    __syncthreads();
    {
        float ov[16]; float ss = 0.f;
#pragma unroll
        for (int e = 0; e < 4; ++e) { const f32x4 q4 = *(const LAS f32x4*)(OF + tn * 132 + 16 * sub + 4 * e); ov[4 * e] = q4[0]; ov[4 * e + 1] = q4[1]; ov[4 * e + 2] = q4[2]; ov[4 * e + 3] = q4[3]; }
#pragma unroll
        for (int e = 0; e < 16; ++e) ss += ov[e] * ov[e];
        ss += __shfl_xor(ss, 1); ss += __shfl_xor(ss, 2); ss += __shfl_xor(ss, 4);
        const float rinv = rsqrtf(ss * (1.f / 128.f) + EPS);
        const unsigned gw[8] = {g0.x, g0.y, g0.z, g0.w, g1.x, g1.y, g1.z, g1.w};
        unsigned pw[8];
#pragma unroll
        for (int e = 0; e < 8; ++e) {
            const float w0 = X.gnorm_w[16 * sub + 2 * e], w1 = X.gnorm_w[16 * sub + 2 * e + 1];
            pw[e] = pk2_rne(ov[2 * e] * rinv * w0 * bflo(gw[e]), ov[2 * e + 1] * rinv * w1 * bfhi(gw[e]));
        }
        bf16_t* yp = (bf16_t*)(X.ws + WS_H) + (size_t)(t0 + tn) * D + 1024 + hd * 128 + 16 * sub;
        *(u32x4*)(yp) = (u32x4){pw[0], pw[1], pw[2], pw[3]}; *(u32x4*)(yp + 8) = (u32x4){pw[4], pw[5], pw[6], pw[7]};
    }
    __syncthreads();
}

__device__ __forceinline__ void phase_scan_combine(Ctx& X) {
    const int gt = blockIdx.x * 512 + X.tid, NT = X.G * 512;
    const bf16_t* P = (const bf16_t*)X.out; const float* DB = (const float*)(X.ws + WS_DBUF); bf16_t* SB = (bf16_t*)(X.ws + WS_SBUF);
    for (int e = gt; e < 131072; e += NT) {
        const int hd = e >> 14, k = e & 127;
        float st = 0.f;
        for (int c0 = 0; c0 < 256; c0 += 8) {
            float pv[8], dv[8];
#pragma unroll
            for (int j = 0; j < 8; ++j) { pv[j] = bf2f(P[(size_t)(c0 + j) * 131072 + e]); dv[j] = DB[((c0 + j) * 8 + hd) * 128 + k]; }
#pragma unroll
            for (int j = 0; j < 8; ++j) { SB[(size_t)(c0 + j) * 131072 + e] = (bf16_t)(pk2_rne(st, 0.f) & 0xffffu); st = dv[j] * st + pv[j]; }
        }
    }
    const bf16_t* OP = (const bf16_t*)(X.ws + WS_OP); const float* LSE = (const float*)(X.ws + WS_LSE); bf16_t* Y = (bf16_t*)(X.ws + WS_H);
    for (int e = gt; e < S * 128; e += NT) {
        const int t = e >> 7, cg8 = e & 127, hd = cg8 >> 4;
        const float l0 = LSE[(size_t)(0 * 8 + hd) * S + t], l1 = LSE[(size_t)(1 * 8 + hd) * S + t], l2 = LSE[(size_t)(2 * 8 + hd) * S + t];
        const float mx = fmaxf(l0, fmaxf(l1, l2));
        float w0 = __builtin_amdgcn_exp2f(l0 - mx), w1 = __builtin_amdgcn_exp2f(l1 - mx), w2 = __builtin_amdgcn_exp2f(l2 - mx);
        const float inv = 1.f / (w0 + w1 + w2); w0 *= inv; w1 *= inv; w2 *= inv;
        const size_t off = (size_t)t * 1024 + cg8 * 8;
        const u32x4 a = *(const u32x4*)(OP + off), b = *(const u32x4*)(OP + TSZ + off), cc = *(const u32x4*)(OP + 2 * TSZ + off);
        u32x4 o;
#pragma unroll
        for (int j = 0; j < 4; ++j) o[j] = pk2_rne(w0 * bflo(a[j]) + w1 * bflo(b[j]) + w2 * bflo(cc[j]), w0 * bfhi(a[j]) + w1 * bfhi(b[j]) + w2 * bfhi(cc[j]));
        *(u32x4*)(Y + (size_t)t * D + cg8 * 8) = o;
    }
}

__device__ __forceinline__ void phase_fixup(Ctx& X) {
    const int gt = blockIdx.x * 512 + X.tid, NT = X.G * 512;
    const float* HALO = (const float*)(X.ws + WS_HALO); const float* HEAD = (const float*)(X.ws + WS_HEAD); bf16_t* ACT = (bf16_t*)(X.ws + WS_ACT);
    for (int it = gt; it < 64 * DFF; it += NT) {
        const int pm = it / DFF, j = it - pm * DFF, ig = 256 * (j >> 7) + (j & 127), iu = ig + 128;
        float gm2 = 0.f, gm1 = 0.f, um2 = 0.f, um1 = 0.f;
        if (pm > 0) { const float* hp = HALO + (size_t)(pm - 1) * 2 * UPW; gm2 = hp[ig]; gm1 = hp[UPW + ig]; um2 = hp[iu]; um1 = hp[UPW + iu]; }
        const float* hd = HEAD + (size_t)pm * 2 * UPW;
        const float g0 = hd[ig], g1 = hd[UPW + ig], u0 = hd[iu], u1 = hd[UPW + iu];
        const float wg0 = X.conv_w[j], wg1 = X.conv_w[UPW + j], wg2 = X.conv_w[2 * UPW + j], bg = X.conv_b[j];
        const float wu0 = X.conv_w[DFF + j], wu1 = X.conv_w[UPW + DFF + j], wu2 = X.conv_w[2 * UPW + DFF + j], bu = X.conv_b[DFF + j];
        const float yg0 = wg0 * gm2 + wg1 * gm1 + wg2 * g0 + bg, yu0 = wu0 * um2 + wu1 * um1 + wu2 * u0 + bu;
        const float yg1 = wg0 * gm1 + wg1 * g0 + wg2 * g1 + bg, yu1 = wu0 * um1 + wu1 * u0 + wu2 * u1 + bu;
        ACT[(size_t)(256 * pm) * DFF + j] = (bf16_t)(pk2_rne(fast_silu(yg0) * yu0, 0.f) & 0xffffu);
        ACT[(size_t)(256 * pm + 1) * DFF + j] = (bf16_t)(pk2_rne(fast_silu(yg1) * yu1, 0.f) & 0xffffu);
    }
}

#define XB_TMO      128
#define XB_XCNT(j)  (256  + 64 * (j))
#define XB_XSUB(j)  (1280 + 64 * (j))
#define XB_XGEN(j)  (2304 + 64 * (j))
#define XB_TOP      3328
#define XB_TOPGEN   3392
#define XCD_BAR_WORDS 3456
#define XB_SPIN_CAP (1u << 20)
__device__ __forceinline__ unsigned xb_ld(unsigned* p)              { return __hip_atomic_load(p, __ATOMIC_RELAXED, __HIP_MEMORY_SCOPE_AGENT); }
__device__ __forceinline__ unsigned xb_add(unsigned* p, unsigned v) { return __hip_atomic_fetch_add(p, v, __ATOMIC_RELAXED, __HIP_MEMORY_SCOPE_AGENT); }
__device__ __forceinline__ unsigned xb_xcc_id() { return (unsigned)__builtin_amdgcn_s_getreg((3 << 11) | 20) & 0xFu; }
#define XB_SPIN(cond, bar) do { unsigned _sp = 0; while (cond) { __builtin_amdgcn_s_sleep(1); \
    if ((++_sp & 255u) == 0u) { if (xb_ld(&(bar)[XB_TMO])) break; if (_sp > XB_SPIN_CAP) { atomicAdd(&(bar)[XB_TMO], 1u); break; } } } } while (0)
struct XcdBarrier { unsigned* bar; unsigned x; volatile LAS unsigned* st; };
__device__ __forceinline__ XcdBarrier xcd_barrier_post(unsigned* bar, volatile LAS unsigned* st) {
    XcdBarrier b; b.bar = bar; b.x = xb_xcc_id(); b.st = st;
    if (threadIdx.x == 0) (void)xb_add(&bar[XB_XCNT(b.x)], 1u);
    return b;
}
__device__ __forceinline__ void xcd_barrier_complete(unsigned* bar, unsigned x, unsigned& nloc, unsigned& nx) {
    const unsigned G = gridDim.x * gridDim.y * gridDim.z;
    unsigned sum, cnt, mine, sp = 0u;
    for (;;) {
        sum = 0u; cnt = 0u; mine = 0u;
#pragma unroll
        for (unsigned j = 0; j < 16; ++j) { const unsigned c = xb_ld(&bar[XB_XCNT(j)]); sum += c; cnt += (c > 0u) ? 1u : 0u; mine = (j == x) ? c : mine; }
        if (sum == G) break;
        __builtin_amdgcn_s_sleep(1);
        if ((++sp & 255u) == 0u) { if (xb_ld(&bar[XB_TMO])) break; if (sp > XB_SPIN_CAP) { atomicAdd(&bar[XB_TMO], 1u); break; } }
    }
    nloc = mine > 0u ? mine : 1u; nx = cnt > 0u ? cnt : 1u;
}
__device__ __forceinline__ void xcd_barrier(const XcdBarrier& b) {
    asm volatile("s_waitcnt vmcnt(0)" ::: "memory");
    __syncthreads();
    if (threadIdx.x == 0) {
        unsigned* bar = b.bar;
        __builtin_amdgcn_s_waitcnt(0);
        unsigned nloc = b.st[0], nx = b.st[1];
        if (nloc == 0u) { xcd_barrier_complete(bar, b.x, nloc, nx); b.st[0] = nloc; b.st[1] = nx; }
        const unsigned old = xb_add(&bar[XB_XSUB(b.x)], 1u);
        const unsigned gen = old / nloc;
        if (old + 1u == (gen + 1u) * nloc) {
            __builtin_amdgcn_fence(__ATOMIC_RELEASE, "agent");
            asm volatile("s_waitcnt vmcnt(0)" ::: "memory");
            const unsigned og = xb_add(&bar[XB_TOP], 1u);
            const unsigned tg = og / nx;
            if (og + 1u == (tg + 1u) * nx) xb_add(&bar[XB_TOPGEN], 1u);
            else XB_SPIN(xb_ld(&bar[XB_TOPGEN]) == tg, bar);
            __builtin_amdgcn_fence(__ATOMIC_ACQUIRE, "agent");
            xb_add(&bar[XB_XGEN(b.x)], 1u);
            asm volatile("s_waitcnt vmcnt(0)" ::: "memory");
        } else {
            XB_SPIN(xb_ld(&bar[XB_XGEN(b.x)]) == gen, bar);
            __builtin_amdgcn_fence(__ATOMIC_ACQUIRE, "agent");
            asm volatile("s_waitcnt vmcnt(0)" ::: "memory");
        }
    }
    __syncthreads();
}

struct Args { const void* in[16]; float* out; unsigned char* ws; int ph_lo, ph_hi; };

__global__ void __launch_bounds__(512, 2) fwd_mega(Args a) {
    extern __shared__ __attribute__((aligned(16))) unsigned char lds_raw[];
    cg::grid_group grid = cg::this_grid();
    Ctx X;
    X.lds = (LAS unsigned char*)lds_raw; X.ws = a.ws; X.out = a.out;
    X.x = (const float*)a.in[0]; X.c = (const float*)a.in[1]; X.pos = (const int*)a.in[2]; X.w_ada = (const float*)a.in[3]; X.b_ada = (const float*)a.in[4];
    X.norm1_w = (const float*)a.in[5]; X.w_in = (const float*)a.in[6]; X.lb_logits = (const float*)a.in[7]; X.gnorm_w = (const float*)a.in[8]; X.w_out = (const float*)a.in[9];
    X.norm2_w = (const float*)a.in[10]; X.w_up = (const float*)a.in[11]; X.conv_w = (const float*)a.in[12]; X.conv_b = (const float*)a.in[13]; X.w_down = (const float*)a.in[14]; X.final_w = (const float*)a.in[15];
    X.tid = threadIdx.x; X.lane = X.tid & 63; X.wave = __builtin_amdgcn_readfirstlane(X.tid >> 6); X.G = gridDim.x;
    X.gw = blockIdx.x * NWAVES + X.wave; X.NGW = X.G * NWAVES;
    const int lo = a.ph_lo, hi = a.ph_hi;
    const float* mod = (const float*)(X.ws + WS_CTL);
    bf16_t* PROJ = (bf16_t*)(X.ws + WS_PROJ);
#define IN(k) (lo <= (k) && (k) < hi)
    volatile LAS unsigned* bst = (volatile LAS unsigned*)(X.lds + LDS_BYTES - 64);
    if (X.tid < 16) bst[X.tid] = 0u;
    __syncthreads();
    XcdBarrier xbar; xbar.bar = (unsigned*)(X.ws + WS_BAR); xbar.x = 0; xbar.st = bst;
    if (hi - lo > 1) xbar = xcd_barrier_post((unsigned*)(X.ws + WS_BAR), bst);
    if (lo < 0) grid.sync();
#define SEAM(k) do { if (IN(k) && IN((k) + 1)) xcd_barrier(xbar); } while (0)

    if (IN(0)) phase_prologue(X);
    SEAM(0);
    if (IN(1)) rows_norm_mod(X, X.x, nullptr, nullptr, X.norm1_w, mod + 2048, mod + 0, (bf16_t*)(X.ws + WS_H), true);
    SEAM(1);
    if (IN(2)) {
        pg8::Gemm g{(const bf16_t*)(X.ws + WS_H), (const bf16_t*)(X.ws + WS_WIN), S, INW, D, D}; pg8::StaticOrder so; so.init(S, INW, X.G, (int)blockIdx.x);
        EpiProj E{PROJ, (const float*)(X.ws + WS_CS), X.lb_logits};
        pg8::gemm_phase<EpiProj, pg8::StaticOrder>(X.lds, g, so, E);
    }
    SEAM(2);
    if (IN(3)) {
        {
            RawA cur; hgrn_a_load(X, blockIdx.x, cur);
            for (int u = blockIdx.x; u < 2048; u += X.G) { RawA nxt = cur; if (u + X.G < 2048) hgrn_a_load(X, u + X.G, nxt); hgrn_a_compute(X, u, cur); cur = nxt; }
        }
        LAS bf16_t* kl = (LAS bf16_t*)(X.lds + X.wave * 17408); LAS bf16_t* vl = kl + 4352;
        if (X.G == 256) {
            const int hd = blockIdx.x & 7, jx = blockIdx.x >> 3;
            bf16_t* OPp = (bf16_t*)(X.ws + WS_OP); float* LSEp = (float*)(X.ws + WS_LSE);
            {
                const int p = jx >> 4, q = jx & 15;
                attn_run_coop(32, p, hd, p ? (q >> 2) : 0, p ? 32 * (q & 3) : 32 * q, PROJ, PROJ + TSZ, PROJ + 2 * TSZ, OPp, LSEp, (LAS bf16_t*)X.lds, X.lane, X.wave);
            }
            attn_run_coop(16, 2, hd, jx >> 1, 16 * (jx & 1), PROJ, PROJ + TSZ, PROJ + 2 * TSZ, OPp, LSEp, (LAS bf16_t*)X.lds, X.lane, X.wave);
        } else {
            const int per = (12288 + X.G - 1) / X.G;
            for (int i = X.wave; i < per; i += NWAVES) {
                const int id = blockIdx.x * per + i;
                if (id < 12288) attn_item(id, PROJ, PROJ + TSZ, PROJ + 2 * TSZ, (bf16_t*)(X.ws + WS_OP), (float*)(X.ws + WS_LSE), kl, vl, X.lane);
            }
        }
    }
    SEAM(3);
    if (IN(4)) phase_scan_combine(X);
    SEAM(4);
    if (IN(5)) {
        RawC cur; hgrn_c_load(X, blockIdx.x, cur);
        for (int u = blockIdx.x; u < 2048; u += X.G) { RawC nxt = cur; if (u + X.G < 2048) hgrn_c_load(X, u + X.G, nxt); hgrn_c_compute(X, u, cur); cur = nxt; }
    }
    SEAM(5);
    if (IN(6)) {
        pg8::Gemm g{(const bf16_t*)(X.ws + WS_H), (const bf16_t*)(X.ws + WS_WOUT), S, D, D, D}; pg8::StaticOrder so; so.init(S, D, X.G, (int)blockIdx.x);
        EpiDelta E{(bf16_t*)(X.ws + WS_D1), mod + 4096};
        pg8::gemm_phase<EpiDelta, pg8::StaticOrder>(X.lds, g, so, E);
    }
    SEAM(6);
    if (IN(7)) rows_norm_mod(X, X.x, (const bf16_t*)(X.ws + WS_D1), nullptr, X.norm2_w, mod + 8192, mod + 6144, (bf16_t*)(X.ws + WS_H2), false);
    SEAM(7);
    if (IN(8)) {
        pg8::Gemm g{(const bf16_t*)(X.ws + WS_H2), (const bf16_t*)(X.ws + WS_WUP), S, UPW, D, D}; pg8::StaticOrder so; so.init(S, UPW, X.G, (int)blockIdx.x);
        EpiUpConv E{(bf16_t*)(X.ws + WS_ACT), (float*)(X.ws + WS_HEAD), (float*)(X.ws + WS_HALO), X.conv_w, X.conv_b, (LAS float*)(X.lds + 131072)};
        pg8::gemm_phase<EpiUpConv, pg8::StaticOrder>(X.lds, g, so, E);
    }
    SEAM(8);
    if (IN(9)) phase_fixup(X);
    SEAM(9);
    if (IN(10)) {
        pg8::Gemm g{(const bf16_t*)(X.ws + WS_ACT), (const bf16_t*)(X.ws + WS_WDOWN), S, D, DFF, DFF}; pg8::StaticOrder so; so.init(S, D, X.G, (int)blockIdx.x);
        EpiDelta E{(bf16_t*)(X.ws + WS_D2), mod + 10240};
        pg8::gemm_phase<EpiDelta, pg8::StaticOrder>(X.lds, g, so, E);
    }
    SEAM(10);
    if (IN(11)) rows_final(X);
#undef IN
#undef SEAM
}

extern "C" void kernel_launch(void* const* d_in, const int* in_sizes, int n_in, void* d_out, int out_size, void* d_ws, size_t ws_size, hipStream_t stream) {
    static int grid = 0;
    if (grid == 0) {
        if (n_in != 16 || out_size != S * D || ws_size < WS_NEED) { fprintf(stderr, "kernel_launch: unexpected shapes (n_in %d, out %d, ws %zu < %zu)\n", n_in, out_size, ws_size, (size_t)WS_NEED); grid = -1; return; }
        int dev = 0, cus = 0, per_cu = 0;
        (void)hipGetDevice(&dev); (void)hipDeviceGetAttribute(&cus, hipDeviceAttributeMultiprocessorCount, dev);
        if (hipFuncSetAttribute((const void*)fwd_mega, hipFuncAttributeMaxDynamicSharedMemorySize, LDS_BYTES) != hipSuccess) { fprintf(stderr, "kernel_launch: hipFuncSetAttribute failed\n"); grid = -1; return; }
        if (hipOccupancyMaxActiveBlocksPerMultiprocessor(&per_cu, (const void*)fwd_mega, 512, LDS_BYTES) != hipSuccess || per_cu < 1) { fprintf(stderr, "kernel_launch: occupancy query says %d\n", per_cu); per_cu = 1; }
        (void)hipGetLastError();
        grid = cus * 1;
        if (grid <= 0) grid = 256;
    }
    if (grid < 0) return;
    (void)hipMemsetAsync((char*)d_ws + WS_CTL, 0, 131072, stream);
    Args a{};
    for (int i = 0; i < 16; ++i) a.in[i] = d_in[i];
    a.out = (float*)d_out; a.ws = (unsigned char*)d_ws;
#if MK_SINGLE
    a.ph_lo = 0; a.ph_hi = NPHASE;
    void* args[] = {&a};
    hipError_t e = hipLaunchCooperativeKernel((const void*)fwd_mega, dim3(grid), dim3(512), args, LDS_BYTES, stream);
    if (e != hipSuccess) fprintf(stderr, "cooperative launch failed: %s (grid %d)\n", hipGetErrorString(e), grid);
#else
    for (int p = 0; p < NPHASE; ++p) { a.ph_lo = p; a.ph_hi = p + 1; hipLaunchKernelGGL(fwd_mega, dim3(grid), dim3(512), LDS_BYTES, stream, a);
#ifdef PROBE_DUP_MASK
        if ((PROBE_DUP_MASK >> p) & 1) hipLaunchKernelGGL(fwd_mega, dim3(grid), dim3(512), LDS_BYTES, stream, a);
#endif
    }
#endif
}
```
